# Optimizing an MI355X kernel written in HIP

```python
import math
import jax, jax.numpy as jnp
from jax import lax
import numpy as np

D_MODEL = 2048
BATCH = 4
SEQ = 4096
DEPTH = 1

MEM_LEN = 256
EPS = 1e-6
Q_BLOCK = 128
NEG_BIG = 1e9

MLA_HEADS = 8
MLA_NOPE = 128
MLA_ROPE = 64
MLA_V = 128
MLA_Q_RANK = 512
MLA_KV_RANK = 512
ROPE_THETA = 10000.0

NSA_HEADS = 4
NSA_DK = 192
NSA_DV = 128
CMP_LEN = 32
CMP_STRIDE = 16
SLC_LEN = 64
SLC_TOPN = 16
WIN = 512

MEM_HEADS = 4
MEM_DH = 128

MLA_WIDTH = MLA_HEADS * MLA_V
NSA_WIDTH = NSA_HEADS * NSA_DV
MEM_WIDTH = MEM_HEADS * MEM_DH
MIX_WIDTH = MLA_WIDTH + NSA_WIDTH + MEM_WIDTH

IN_SPLITS = (
    MLA_Q_RANK, MLA_KV_RANK, MLA_ROPE, MLA_WIDTH,
    NSA_HEADS * NSA_DK, NSA_DK, NSA_DV, NSA_DK, NSA_DV,
    NSA_DK, NSA_DV, 3 * NSA_HEADS, NSA_WIDTH,
    MEM_WIDTH, MEM_WIDTH,
)
D_IN = sum(IN_SPLITS)

kernel_name = "hybrid_mla_nsa_memory_block"


def rmsnorm(x, g):
    xf = x.astype(jnp.float32)
    y = xf * lax.rsqrt(jnp.mean(xf * xf, axis=-1, keepdims=True) + EPS)
    return (y * g.astype(jnp.float32)).astype(x.dtype)


def masked_softmax(s, mask):
    s = jnp.where(mask, s.astype(jnp.float32), -1e30)
    m = jnp.max(s, axis=-1, keepdims=True)
    p = jnp.exp(s - m) * mask
    return p / (jnp.sum(p, axis=-1, keepdims=True) + 1e-20)


def alibi_slopes(n):
    return 2.0 ** (-8.0 * jnp.arange(1, n + 1, dtype=jnp.float32) / n)


def apply_rope(x, cos, sin):
    x1, x2 = jnp.split(x.astype(jnp.float32), 2, axis=-1)
    return jnp.concatenate([x1 * cos - x2 * sin, x1 * sin + x2 * cos], axis=-1).astype(x.dtype)


def to_blocks(a):
    b, s = a.shape[:2]
    return jnp.moveaxis(a.reshape(b, s // Q_BLOCK, Q_BLOCK, *a.shape[2:]), 1, 0)


def from_blocks(a):
    a = jnp.moveaxis(a, 0, 1)
    return a.reshape(a.shape[0], -1, *a.shape[3:])


def mla_mixer(c_q, c_kv, k_rope, cos, sin, q_norm_g, w_uq, kv_norm_g, w_ukv):
    b, s, _ = c_q.shape
    q = (rmsnorm(c_q, q_norm_g) @ w_uq).reshape(b, s, MLA_HEADS, MLA_NOPE + MLA_ROPE)
    q = jnp.concatenate([q[..., :MLA_NOPE],
                         apply_rope(q[..., MLA_NOPE:], cos[:, None], sin[:, None])], axis=-1)
    kv = (rmsnorm(c_kv, kv_norm_g) @ w_ukv).reshape(b, s, MLA_HEADS, MLA_NOPE + MLA_V)
    k_pe = apply_rope(k_rope, cos, sin)
    k = jnp.concatenate([kv[..., :MLA_NOPE],
                         jnp.broadcast_to(k_pe[:, :, None], (b, s, MLA_HEADS, MLA_ROPE))], axis=-1)
    v = kv[..., MLA_NOPE:]
    scale = (MLA_NOPE + MLA_ROPE) ** -0.5
    kpos = jnp.arange(s)

    def block(args):
        qb, i = args
        qpos = i * Q_BLOCK + jnp.arange(Q_BLOCK)
        sc = jnp.einsum('bqhd,bkhd->bhqk', qb, k, preferred_element_type=jnp.float32) * scale
        p = masked_softmax(sc, kpos[None, :] <= qpos[:, None])
        return jnp.einsum('bhqk,bkhd->bqhd', p.astype(v.dtype), v)

    o = lax.map(block, (to_blocks(q), jnp.arange(s // Q_BLOCK)))
    return from_blocks(o).reshape(b, s, MLA_WIDTH)


def compress(a, pe, w1, w2):
    b, s, d = a.shape
    ch = a.reshape(b, s // CMP_STRIDE, CMP_STRIDE, d)
    blocks = jnp.concatenate([ch[:, :-1], ch[:, 1:]], axis=2) + pe
    return jax.nn.silu(blocks.reshape(b, -1, CMP_LEN * d) @ w1) @ w2


def nsa_mixer(q, k_c, v_c, k_s, v_s, k_w, v_w, gate_logits,
              cmp_pe_k, cmp_pe_v, cmp_w1k, cmp_w2k, cmp_w1v, cmp_w2v):
    b, s, _ = q.shape
    q = q.reshape(b, s, NSA_HEADS, NSA_DK)
    gates = jax.nn.sigmoid(gate_logits.astype(jnp.float32)).reshape(b, s, NSA_HEADS, 3)
    scale = NSA_DK ** -0.5
    slopes = alibi_slopes(NSA_HEADS)[None, :, None, None]

    k_cmp = compress(k_c, cmp_pe_k, cmp_w1k, cmp_w2k)
    v_cmp = compress(v_c, cmp_pe_v, cmp_w1v, cmp_w2v)
    n_c = k_cmp.shape[1]
    c_start = jnp.arange(n_c) * CMP_STRIDE
    cmp_end = c_start + CMP_LEN - 1
    cmp_pos = c_start.astype(jnp.float32) + (CMP_LEN - 1) / 2.0

    n_s = s // SLC_LEN
    top_n = min(SLC_TOPN, n_s)
    k_blk = k_s.reshape(b, n_s, SLC_LEN, NSA_DK)
    v_blk = v_s.reshape(b, n_s, SLC_LEN, NSA_DV)
    s_start = jnp.arange(n_s) * SLC_LEN
    overlap = ((c_start[:, None] < s_start[None, :] + SLC_LEN) &
               (c_start[:, None] + CMP_LEN > s_start[None, :])).astype(jnp.float32)
    j = jnp.arange(n_s)

    k_wp = jnp.pad(k_w, ((0, 0), (WIN, 0), (0, 0)))
    v_wp = jnp.pad(v_w, ((0, 0), (WIN, 0), (0, 0)))

    def block(args):
        qb, gb, i = args
        t = i * Q_BLOCK + jnp.arange(Q_BLOCK)
        tf = t.astype(jnp.float32)

        sc = jnp.einsum('bqhd,bnd->bhqn', qb, k_cmp, preferred_element_type=jnp.float32) * scale
        sc = sc - slopes * (tf[:, None] - cmp_pos[None, :])
        p_cmp = masked_softmax(sc, cmp_end[None, :] <= t[:, None])
        o_cmp = jnp.einsum('bhqn,bnd->bqhd', p_cmp.astype(v_cmp.dtype), v_cmp)

        imp = jnp.einsum('bhqn,nm->bqm', p_cmp, overlap)
        cur = t // SLC_LEN
        forced = (j[None, :] == 0) | (j[None, :] == cur[:, None]) | (j[None, :] == cur[:, None] - 1)
        imp = jnp.where(forced, NEG_BIG, imp)
        imp = jnp.where(j[None, :] > cur[:, None], -NEG_BIG, imp)
        _, idx = lax.top_k(imp, top_n)
        ks = jax.vmap(lambda kb, ix: kb[ix])(k_blk, idx)
        vs = jax.vmap(lambda vb, ix: vb[ix])(v_blk, idx).reshape(b, Q_BLOCK, top_n * SLC_LEN, NSA_DV)
        spos = (idx[..., None] * SLC_LEN + jnp.arange(SLC_LEN)).reshape(b, Q_BLOCK, top_n * SLC_LEN)
        ss = jnp.einsum('bqhd,bqnld->bhqnl', qb, ks, preferred_element_type=jnp.float32)
        ss = ss.reshape(b, NSA_HEADS, Q_BLOCK, top_n * SLC_LEN) * scale
        ss = ss - slopes * (tf[None, None, :, None] - spos[:, None].astype(jnp.float32))
        p_s = masked_softmax(ss, (spos <= t[None, :, None])[:, None])
        o_slc = jnp.einsum('bhqk,bqkd->bqhd', p_s.astype(vs.dtype), vs)

        kw = lax.dynamic_slice_in_dim(k_wp, i * Q_BLOCK, WIN + Q_BLOCK, axis=1)
        vw = lax.dynamic_slice_in_dim(v_wp, i * Q_BLOCK, WIN + Q_BLOCK, axis=1)
        wpos = i * Q_BLOCK - WIN + jnp.arange(WIN + Q_BLOCK)
        rel = t[:, None] - wpos[None, :]
        sw = jnp.einsum('bqhd,bkd->bhqk', qb, kw, preferred_element_type=jnp.float32) * scale
        sw = sw - slopes * rel.astype(jnp.float32)
        p_w = masked_softmax(sw, (rel >= 0) & (rel < WIN) & (wpos[None, :] >= 0))
        o_win = jnp.einsum('bhqk,bkd->bqhd', p_w.astype(vw.dtype), vw)

        o = gb[..., 0:1] * o_cmp + gb[..., 1:2] * o_slc + gb[..., 2:3] * o_win
        return o.astype(qb.dtype)

    o = lax.map(block, (to_blocks(q), to_blocks(gates), jnp.arange(s // Q_BLOCK)))
    return from_blocks(o).reshape(b, s, NSA_WIDTH)


def memory_mixer(q, mem, mem_norm_g, w_mem_kv):
    b, s, _ = q.shape
    q = q.reshape(b, s, MEM_HEADS, MEM_DH)
    kv = (rmsnorm(mem, mem_norm_g) @ w_mem_kv).reshape(b, mem.shape[1], 2, MEM_HEADS, MEM_DH)
    k, v = kv[:, :, 0], kv[:, :, 1]
    sc = jnp.einsum('bshd,bmhd->bhsm', q, k, preferred_element_type=jnp.float32) * MEM_DH ** -0.5
    p = jax.nn.softmax(sc, axis=-1)
    return jnp.einsum('bhsm,bmhd->bshd', p.astype(v.dtype), v).reshape(b, s, MEM_WIDTH)


def hybrid_layer(x, mem, cos, sin, norm_g, w_in, q_norm_g, w_uq, kv_norm_g, w_ukv,
                 cmp_pe_k, cmp_pe_v, cmp_w1k, cmp_w2k, cmp_w1v, cmp_w2v,
                 mem_norm_g, w_mem_kv, w_out):
    h = rmsnorm(x, norm_g) @ w_in
    offsets = np.cumsum(IN_SPLITS)[:-1].tolist()
    (c_q, c_kv, k_rope, z_mla, q_nsa, k_c, v_c, k_s, v_s, k_w, v_w, g_nsa, z_nsa,
     q_mem, z_mem) = jnp.split(h, offsets, axis=-1)
    o_mla = mla_mixer(c_q, c_kv, k_rope, cos, sin, q_norm_g, w_uq, kv_norm_g, w_ukv) * jax.nn.silu(z_mla)
    o_nsa = nsa_mixer(q_nsa, k_c, v_c, k_s, v_s, k_w, v_w, g_nsa,
                      cmp_pe_k, cmp_pe_v, cmp_w1k, cmp_w2k, cmp_w1v, cmp_w2v) * jax.nn.silu(z_nsa)
    o_mem = memory_mixer(q_mem, mem, mem_norm_g, w_mem_kv) * jax.nn.silu(z_mem)
    o = jnp.concatenate([o_mla, o_nsa, o_mem], axis=-1) @ w_out
    return x + o.astype(x.dtype)


def setup_inputs(seed: int = 0) -> dict:
    key = jax.random.key(seed)
    ks = jax.random.split(key, 20)

    def nrm(k, shape, scale):
        return jax.random.normal(k, shape, jnp.float32) * scale

    def gain(k, shape):
        return 1.0 + 0.01 * jax.random.normal(k, shape, jnp.float32)

    return {
        "x": nrm(ks[0], (BATCH, SEQ, D_MODEL), 1.0),
        "mem": nrm(ks[1], (BATCH, MEM_LEN, D_MODEL), 1.0),
        "norm_g": gain(ks[2], (DEPTH, D_MODEL)),
        "w_in": nrm(ks[3], (DEPTH, D_MODEL, D_IN), D_MODEL ** -0.5),
        "q_norm_g": gain(ks[4], (DEPTH, MLA_Q_RANK)),
        "w_uq": nrm(ks[5], (DEPTH, MLA_Q_RANK, MLA_HEADS * (MLA_NOPE + MLA_ROPE)), MLA_Q_RANK ** -0.5),
        "kv_norm_g": gain(ks[6], (DEPTH, MLA_KV_RANK)),
        "w_ukv": nrm(ks[7], (DEPTH, MLA_KV_RANK, MLA_HEADS * (MLA_NOPE + MLA_V)), MLA_KV_RANK ** -0.5),
        "cmp_pe_k": nrm(ks[8], (DEPTH, CMP_LEN, NSA_DK), 0.02),
        "cmp_pe_v": nrm(ks[9], (DEPTH, CMP_LEN, NSA_DV), 0.02),
        "cmp_w1k": nrm(ks[10], (DEPTH, CMP_LEN * NSA_DK, NSA_DK), (CMP_LEN * NSA_DK) ** -0.5),
        "cmp_w2k": nrm(ks[11], (DEPTH, NSA_DK, NSA_DK), NSA_DK ** -0.5),
        "cmp_w1v": nrm(ks[12], (DEPTH, CMP_LEN * NSA_DV, NSA_DV), (CMP_LEN * NSA_DV) ** -0.5),
        "cmp_w2v": nrm(ks[13], (DEPTH, NSA_DV, NSA_DV), NSA_DV ** -0.5),
        "mem_norm_g": gain(ks[14], (DEPTH, D_MODEL)),
        "w_mem_kv": nrm(ks[15], (DEPTH, D_MODEL, 2 * MEM_WIDTH), D_MODEL ** -0.5),
        "w_out": nrm(ks[16], (DEPTH, MIX_WIDTH, D_MODEL), MIX_WIDTH ** -0.5),
        "final_norm_g": gain(ks[17], (D_MODEL,)),
    }


def reference(x, mem, norm_g, w_in, q_norm_g, w_uq, kv_norm_g, w_ukv,
              cmp_pe_k, cmp_pe_v, cmp_w1k, cmp_w2k, cmp_w1v, cmp_w2v,
              mem_norm_g, w_mem_kv, w_out, final_norm_g):
    s = x.shape[1]
    pos = jnp.arange(s, dtype=jnp.float32)
    inv_freq = ROPE_THETA ** (-jnp.arange(0, MLA_ROPE, 2, dtype=jnp.float32) / MLA_ROPE)
    ang = pos[:, None] * inv_freq[None, :]
    cos, sin = jnp.cos(ang), jnp.sin(ang)
    for l in range(DEPTH):
        x = hybrid_layer(x, mem, cos, sin, norm_g[l], w_in[l], q_norm_g[l], w_uq[l],
                         kv_norm_g[l], w_ukv[l], cmp_pe_k[l], cmp_pe_v[l], cmp_w1k[l],
                         cmp_w2k[l], cmp_w1v[l], cmp_w2v[l], mem_norm_g[l], w_mem_kv[l], w_out[l])
    return rmsnorm(x, final_norm_g)
```

```cpp
#include <hip/hip_runtime.h>
#include <hip/hip_cooperative_groups.h>
#include <stdint.h>
#include <cstdio>
namespace cg = cooperative_groups;

typedef unsigned short bfu;
typedef __attribute__((ext_vector_type(8))) short bf16x8;
typedef __attribute__((ext_vector_type(4))) float f32x4;
typedef __attribute__((ext_vector_type(16))) float f32x16;
typedef __attribute__((ext_vector_type(2))) __bf16 bf2_t;
typedef __attribute__((ext_vector_type(4))) unsigned u32x4;
#define DI __device__ __forceinline__

#ifndef MULTI_LAUNCH
#define MULTI_LAUNCH 0
#endif

constexpr int SEQ = 4096, NTOK = 16384, DM = 2048, DIN = 5388, DINP = 5504;
constexpr float EPS = 1e-6f;
constexpr float LOG2E = 1.4426950408889634f;
constexpr int SMEM_BYTES = 81920;

constexpr size_t al(size_t x) { return (x + 255) & ~size_t(255); }
constexpr size_t O_WT_IN  = 0;
constexpr size_t O_WT_UQ  = O_WT_IN  + al((size_t)DINP * 2048 * 2);
constexpr size_t O_WT_UKV = O_WT_UQ  + al((size_t)1536 * 512 * 2);
constexpr size_t O_WT_C1K = O_WT_UKV + al((size_t)2048 * 512 * 2);
constexpr size_t O_WT_C1V = O_WT_C1K + al((size_t)256 * 6144 * 2);
constexpr size_t O_WT_C2K = O_WT_C1V + al((size_t)128 * 4096 * 2);
constexpr size_t O_WT_C2V = O_WT_C2K + al((size_t)256 * 192 * 2);
constexpr size_t O_WT_MKV = O_WT_C2V + al((size_t)128 * 128 * 2);
constexpr size_t O_WT_OUT = O_WT_MKV + al((size_t)1024 * 2048 * 2);
constexpr size_t O_BIASK  = O_WT_OUT + al((size_t)2048 * 2048 * 2);
constexpr size_t O_BIASV  = O_BIASK  + al((size_t)32 * 256 * 4);
constexpr size_t O_COS    = O_BIASV  + al((size_t)32 * 256 * 4);
constexpr size_t O_SIN    = O_COS    + al((size_t)4096 * 32 * 4);
constexpr size_t O_XN     = O_SIN    + al((size_t)4096 * 32 * 4);
constexpr size_t O_MEMN   = O_XN     + al((size_t)NTOK * 2048 * 2);
constexpr size_t O_CQ     = O_MEMN   + al((size_t)1024 * 2048 * 2);
constexpr size_t O_CKV    = O_CQ     + al((size_t)NTOK * 512 * 2);
constexpr size_t O_KPE    = O_CKV    + al((size_t)NTOK * 512 * 2);
constexpr size_t O_ZS     = O_KPE    + al((size_t)NTOK * 64 * 2);
constexpr size_t O_QNSA   = O_ZS     + al((size_t)NTOK * 2048 * 2);
constexpr size_t O_KC     = O_QNSA   + al((size_t)NTOK * 768 * 2);
constexpr size_t O_VC     = O_KC     + al((size_t)(NTOK + 64) * 192 * 2);
constexpr size_t O_KS     = O_VC     + al((size_t)(NTOK + 64) * 128 * 2);
constexpr size_t O_VST    = O_KS     + al((size_t)NTOK * 192 * 2);
constexpr size_t O_KW     = O_VST    + al((size_t)NTOK * 128 * 2);
constexpr size_t O_VWT    = O_KW     + al((size_t)NTOK * 192 * 2);
constexpr size_t O_GATES  = O_VWT    + al((size_t)NTOK * 128 * 2);
constexpr size_t O_QMEM   = O_GATES  + al((size_t)NTOK * 16 * 4);
constexpr size_t O_QMLA   = O_QMEM   + al((size_t)NTOK * 512 * 2);
constexpr size_t O_KNOPE  = O_QMLA   + al((size_t)NTOK * 1536 * 2);
constexpr size_t O_VMLAT  = O_KNOPE  + al((size_t)NTOK * 1024 * 2);
constexpr size_t O_H1K    = O_VMLAT  + al((size_t)NTOK * 1024 * 2);
constexpr size_t O_H1V    = O_H1K    + al((size_t)1024 * 192 * 2);
constexpr size_t O_KCMP   = O_H1V    + al((size_t)1024 * 128 * 2);
constexpr size_t O_VCMPT  = O_KCMP   + al((size_t)1024 * 192 * 2);
constexpr size_t O_MEMK   = O_VCMPT  + al((size_t)1024 * 128 * 2);
constexpr size_t O_MEMVT  = O_MEMK   + al((size_t)1024 * 512 * 2);
constexpr size_t O_OCAT   = O_MEMVT  + al((size_t)1024 * 512 * 2);
constexpr size_t O_ONSA   = O_OCAT   + al((size_t)NTOK * 2048 * 2);
constexpr size_t O_SSQP   = O_ONSA   + al((size_t)NTOK * 512 * 4);
constexpr size_t O_CTR    = O_SSQP   + al((size_t)NTOK * 32 * 4);
constexpr size_t WS_TOTAL = O_CTR    + 256;

struct Params {
  const float *x, *mem, *norm_g, *w_in, *q_norm_g, *w_uq, *kv_norm_g, *w_ukv, *cmp_pe_k, *cmp_pe_v,
              *cmp_w1k, *cmp_w2k, *cmp_w1v, *cmp_w2v, *mem_norm_g, *w_mem_kv, *w_out, *final_g;
  float* out;
  char* ws;
  int phase_lo, phase_hi;
};

__constant__ float INVF[32] = {1.000000000e+00f, 7.498942093e-01f, 5.623413252e-01f, 4.216965034e-01f, 3.162277660e-01f, 2.371373706e-01f, 1.778279410e-01f, 1.333521432e-01f, 1.000000000e-01f, 7.498942093e-02f, 5.623413252e-02f, 4.216965034e-02f, 3.162277660e-02f, 2.371373706e-02f, 1.778279410e-02f, 1.333521432e-02f, 1.000000000e-02f, 7.498942093e-03f, 5.623413252e-03f, 4.216965034e-03f, 3.162277660e-03f, 2.371373706e-03f, 1.778279410e-03f, 1.333521432e-03f, 1.000000000e-03f, 7.498942093e-04f, 5.623413252e-04f, 4.216965034e-04f, 3.162277660e-04f, 2.371373706e-04f, 1.778279410e-04f, 1.333521432e-04f};

DI unsigned pk2(float a, float b) { bf2_t v; v[0] = (__bf16)a; v[1] = (__bf16)b; return __builtin_bit_cast(unsigned, v); }
DI bfu f2b(float a) { return __builtin_bit_cast(unsigned short, (__bf16)a); }
DI float b2f(bfu v) { return __uint_as_float(((unsigned)v) << 16); }
DI float blo(unsigned v) { return __uint_as_float(v << 16); }
DI float bhi(unsigned v) { return __uint_as_float(v & 0xffff0000u); }
DI float siluf(float z) { return z / (1.f + __expf(-z)); }
DI int otid() { int t = threadIdx.x; asm volatile("" : "+v"(t)); return t; }
DI float wave_sum(float v) {
#pragma unroll
  for (int o = 32; o >= 1; o >>= 1) v += __shfl_xor(v, o);
  return v;
}
DI float xhalf_max(float v) {
  auto rr = __builtin_amdgcn_permlane32_swap(__float_as_uint(v), __float_as_uint(v), false, false);
  return fmaxf(__uint_as_float(rr[0]), __uint_as_float(rr[1]));
}
DI float xhalf_sum(float v) {
  auto rr = __builtin_amdgcn_permlane32_swap(__float_as_uint(v), __float_as_uint(v), false, false);
  return __uint_as_float(rr[0]) + __uint_as_float(rr[1]);
}

constexpr int G_LD = 72;
template <bool SSQ, class Epi>
DI void gemm_tile(const bfu* __restrict__ A, long lda, const bfu* __restrict__ Bt, long ldb, int K, int row0, int col0,
                  const Epi& epi, char* smem) {
  bfu* sA = (bfu*)smem;
  bfu* sB = sA + 2 * 128 * G_LD;
  float* rs = (float*)(sB + 2 * 128 * G_LD);
  const int tid = otid(), lane = tid & 63, wave = tid >> 6;
  const int wm = wave >> 1, wn = wave & 1, l15 = lane & 15, quad = lane >> 4;
  const int srow = tid >> 3, skc = tid & 7;
  const bfu* ga = A + (long)(row0 + srow) * lda + skc * 8;
  const bfu* gb = Bt + (long)(col0 + srow) * ldb + skc * 8;
  f32x4 acc[4][4];
#pragma unroll
  for (int i = 0; i < 4; ++i)
#pragma unroll
    for (int j = 0; j < 4; ++j) acc[i][j] = f32x4{0.f, 0.f, 0.f, 0.f};
  uint4 ra[4], rb[4];
  float ssq[4] = {0.f, 0.f, 0.f, 0.f};
  const int nk = K >> 6;
#pragma unroll
  for (int i = 0; i < 4; ++i) { ra[i] = *(const uint4*)(ga + (long)(32 * i) * lda); rb[i] = *(const uint4*)(gb + (long)(32 * i) * ldb); }
#pragma unroll
  for (int i = 0; i < 4; ++i) {
    *(uint4*)(sA + (srow + 32 * i) * G_LD + skc * 8) = ra[i];
    *(uint4*)(sB + (srow + 32 * i) * G_LD + skc * 8) = rb[i];
    if (SSQ) { float a0 = blo(ra[i].x), a1 = bhi(ra[i].x), a2 = blo(ra[i].y), a3 = bhi(ra[i].y), a4 = blo(ra[i].z), a5 = bhi(ra[i].z), a6 = blo(ra[i].w), a7 = bhi(ra[i].w);
      ssq[i] += a0 * a0 + a1 * a1 + a2 * a2 + a3 * a3 + a4 * a4 + a5 * a5 + a6 * a6 + a7 * a7; }
  }
  __syncthreads();
  for (int kt = 0; kt < nk; ++kt) {
    const int buf = kt & 1;
    const bool more = (kt + 1 < nk);
    if (more) {
#pragma unroll
      for (int i = 0; i < 4; ++i) { ra[i] = *(const uint4*)(ga + (long)(32 * i) * lda + (kt + 1) * 64); rb[i] = *(const uint4*)(gb + (long)(32 * i) * ldb + (kt + 1) * 64); }
    }
    const bfu* pa = sA + buf * 128 * G_LD + (wm * 64 + l15) * G_LD + quad * 8;
    const bfu* pb = sB + buf * 128 * G_LD + (wn * 64 + l15) * G_LD + quad * 8;
#pragma unroll
    for (int ks = 0; ks < 2; ++ks) {
      bf16x8 a[4], b[4];
#pragma unroll
      for (int i = 0; i < 4; ++i) { a[i] = *(const bf16x8*)(pa + i * 16 * G_LD + ks * 32); b[i] = *(const bf16x8*)(pb + i * 16 * G_LD + ks * 32); }
#pragma unroll
      for (int i = 0; i < 4; ++i)
#pragma unroll
        for (int j = 0; j < 4; ++j) acc[i][j] = __builtin_amdgcn_mfma_f32_16x16x32_bf16(a[i], b[j], acc[i][j], 0, 0, 0);
    }
    if (more) {
      const int nb = buf ^ 1;
#pragma unroll
      for (int i = 0; i < 4; ++i) {
        *(uint4*)(sA + nb * 128 * G_LD + (srow + 32 * i) * G_LD + skc * 8) = ra[i];
        *(uint4*)(sB + nb * 128 * G_LD + (srow + 32 * i) * G_LD + skc * 8) = rb[i];
        if (SSQ) { float a0 = blo(ra[i].x), a1 = bhi(ra[i].x), a2 = blo(ra[i].y), a3 = bhi(ra[i].y), a4 = blo(ra[i].z), a5 = bhi(ra[i].z), a6 = blo(ra[i].w), a7 = bhi(ra[i].w);
          ssq[i] += a0 * a0 + a1 * a1 + a2 * a2 + a3 * a3 + a4 * a4 + a5 * a5 + a6 * a6 + a7 * a7; }
      }
    }
    __syncthreads();
  }
  if (SSQ) {
#pragma unroll
    for (int i = 0; i < 4; ++i) {
      float v = ssq[i];
      v += __shfl_xor(v, 1); v += __shfl_xor(v, 2); v += __shfl_xor(v, 4);
      if (skc == 0) rs[srow + 32 * i] = rsqrtf(v / (float)K + EPS);
    }
    __syncthreads();
#pragma unroll
    for (int mi = 0; mi < 4; ++mi)
#pragma unroll
      for (int j = 0; j < 4; ++j) {
        float r = rs[wm * 64 + mi * 16 + quad * 4 + j];
#pragma unroll
        for (int ni = 0; ni < 4; ++ni) acc[mi][ni][j] *= r;
      }
  }
#pragma unroll
  for (int mi = 0; mi < 4; ++mi) epi(row0 + wm * 64 + mi * 16 + quad * 4, col0 + wn * 64, l15, acc[mi]);
  if (SSQ) __syncthreads();
}

DI void st_rows(bfu* dst, long ld, int r4, int col, int l15, const f32x4 (&a)[4], float sc) {
#pragma unroll
  for (int j = 0; j < 4; ++j)
#pragma unroll
    for (int ni = 0; ni < 4; ++ni) dst[(long)(r4 + j) * ld + col + ni * 16 + l15] = f2b(a[ni][j] * sc);
}
DI void st_T(bfu* dstT, long ldt, int dcol0, int t4, int l15, const f32x4 (&a)[4]) {
#pragma unroll
  for (int ni = 0; ni < 4; ++ni) {
    uint2 v; v.x = pk2(a[ni][0], a[ni][1]); v.y = pk2(a[ni][2], a[ni][3]);
    *(uint2*)(dstT + (long)(dcol0 + ni * 16 + l15) * ldt + t4) = v;
  }
}
DI void rope4(f32x4 (&o)[4], const f32x4 (&a)[4], const float* cs, const float* sn, int r4, int l15) {
#pragma unroll
  for (int j = 0; j < 4; ++j) {
    int pos = (r4 + j) & (SEQ - 1);
#pragma unroll
    for (int n = 0; n < 2; ++n) {
      float c = cs[pos * 32 + n * 16 + l15], s = sn[pos * 32 + n * 16 + l15];
      float x1 = a[n][j], x2 = a[n + 2][j];
      o[n][j] = x1 * c - x2 * s; o[n + 2][j] = x1 * s + x2 * c;
    }
  }
}

struct EpiInProj {
  char* ws;
  DI void operator()(int r4, int c0, int l15, const f32x4 (&a)[4]) const {
    const int b = r4 >> 12, t4 = r4 & (SEQ - 1);
    if (c0 < 512) st_rows((bfu*)(ws + O_CQ), 512, r4, c0, l15, a, 1.f);
    else if (c0 < 1024) st_rows((bfu*)(ws + O_CKV), 512, r4, c0 - 512, l15, a, 1.f);
    else if (c0 < 1088) { f32x4 o[4]; rope4(o, a, (const float*)(ws + O_COS), (const float*)(ws + O_SIN), r4, l15); st_rows((bfu*)(ws + O_KPE), 64, r4, 0, l15, o, 1.f); }
    else if (c0 < 2112 || (c0 >= 3968 && c0 < 4480) || c0 >= 4992) {
      int zc = (c0 < 2112) ? c0 - 1088 : (c0 < 4480 ? c0 - 3968 + 1024 : c0 - 4992 + 1536);
      bfu* dst = (bfu*)(ws + O_ZS);
#pragma unroll
      for (int j = 0; j < 4; ++j)
#pragma unroll
        for (int ni = 0; ni < 4; ++ni) dst[(long)(r4 + j) * 2048 + zc + ni * 16 + l15] = f2b(siluf(a[ni][j]));
    }
    else if (c0 < 2880) st_rows((bfu*)(ws + O_QNSA), 768, r4, c0 - 2112, l15, a, 0.07216878364870322f * LOG2E);
    else if (c0 < 3072) st_rows((bfu*)(ws + O_KC), 192, r4, c0 - 2880, l15, a, 1.f);
    else if (c0 < 3200) st_rows((bfu*)(ws + O_VC), 128, r4, c0 - 3072, l15, a, 1.f);
    else if (c0 < 3392) st_rows((bfu*)(ws + O_KS), 192, r4, c0 - 3200, l15, a, 1.f);
    else if (c0 < 3520) st_T((bfu*)(ws + O_VST) + (long)b * 128 * SEQ, SEQ, c0 - 3392, t4, l15, a);
    else if (c0 < 3712) st_rows((bfu*)(ws + O_KW), 192, r4, c0 - 3520, l15, a, 1.f);
    else if (c0 < 3840) st_T((bfu*)(ws + O_VWT) + (long)b * 128 * SEQ, SEQ, c0 - 3712, t4, l15, a);
    else if (c0 < 3904) {
      if (l15 < 12) {
        float* g = (float*)(ws + O_GATES);
#pragma unroll
        for (int j = 0; j < 4; ++j) g[(long)(r4 + j) * 16 + l15] = 1.f / (1.f + __expf(-a[0][j]));
      }
    }
    else if (c0 < 3968) {}
    else st_rows((bfu*)(ws + O_QMEM), 512, r4, c0 - 4480, l15, a, 0.08838834764831845f * LOG2E);
  }
};
struct EpiMemKV {
  char* ws;
  DI void operator()(int r4, int c0, int l15, const f32x4 (&a)[4]) const {
    if (c0 < 512) st_rows((bfu*)(ws + O_MEMK), 512, r4, c0, l15, a, 1.f);
    else { int b = r4 >> 8, m4 = r4 & 255; st_T((bfu*)(ws + O_MEMVT) + (long)b * 512 * 256, 256, c0 - 512, m4, l15, a); }
  }
};
struct EpiUQ {
  char* ws;
  DI void operator()(int r4, int c0, int l15, const f32x4 (&a)[4]) const {
    const float sc = 0.07216878364870322f * LOG2E;
    if ((c0 % 192) == 128) { f32x4 o[4]; rope4(o, a, (const float*)(ws + O_COS), (const float*)(ws + O_SIN), r4, l15); st_rows((bfu*)(ws + O_QMLA), 1536, r4, c0, l15, o, sc); }
    else st_rows((bfu*)(ws + O_QMLA), 1536, r4, c0, l15, a, sc);
  }
};
struct EpiUKV {
  char* ws;
  DI void operator()(int r4, int c0, int l15, const f32x4 (&a)[4]) const {
    const int head = c0 >> 8, within = c0 & 255;
    if (within < 128) st_rows((bfu*)(ws + O_KNOPE), 1024, r4, head * 128 + within, l15, a, 1.f);
    else { int b = r4 >> 12, t4 = r4 & (SEQ - 1); st_T((bfu*)(ws + O_VMLAT) + (long)(b * 8 + head) * 128 * SEQ, SEQ, within - 128, t4, l15, a); }
  }
};
struct EpiC1 {
  const float* biasp; bfu* dst; int N;
  DI void operator()(int r4, int c0, int l15, const f32x4 (&a)[4]) const {
#pragma unroll
    for (int ni = 0; ni < 4; ++ni) {
      int n = c0 + ni * 16 + l15;
      if (n < N) {
        float bsum = 0.f;
        for (int ch = 0; ch < 32; ++ch) bsum += biasp[ch * 256 + n];
#pragma unroll
        for (int j = 0; j < 4; ++j) dst[(long)(r4 + j) * N + n] = f2b(siluf(a[ni][j] + bsum));
      }
    }
  }
};
struct EpiC2K {
  char* ws;
  DI void operator()(int r4, int c0, int l15, const f32x4 (&a)[4]) const {
    bfu* dst = (bfu*)(ws + O_KCMP);
#pragma unroll
    for (int ni = 0; ni < 4; ++ni) { int n = c0 + ni * 16 + l15;
      if (n < 192) {
#pragma unroll
        for (int j = 0; j < 4; ++j) dst[(long)(r4 + j) * 192 + n] = f2b(a[ni][j]); } }
  }
};
struct EpiC2V {
  char* ws;
  DI void operator()(int r4, int c0, int l15, const f32x4 (&a)[4]) const {
    int b = r4 >> 8, n4 = r4 & 255;
    st_T((bfu*)(ws + O_VCMPT) + (long)b * 128 * 256, 256, c0, n4, l15, a);
  }
};
struct EpiOut {
  const float* x; float* out; float* ssqp;
  DI void operator()(int r4, int c0, int l15, const f32x4 (&a)[4]) const {
#pragma unroll
    for (int j = 0; j < 4; ++j) {
      float ss = 0.f;
#pragma unroll
      for (int ni = 0; ni < 4; ++ni) {
        long idx = (long)(r4 + j) * DM + c0 + ni * 16 + l15;
        float y = a[ni][j] + x[idx];
        out[idx] = y; ss += y * y;
      }
      ss += __shfl_xor(ss, 1); ss += __shfl_xor(ss, 2); ss += __shfl_xor(ss, 4); ss += __shfl_xor(ss, 8);
      if (l15 == 0) ssqp[(long)(r4 + j) * 32 + (c0 >> 6)] = ss;
    }
  }
};

DI void rms_row(const float* __restrict__ src, const float* __restrict__ g, bfu* __restrict__ dst, int lane) {
  const float4* s4 = (const float4*)src;
  float4 v[8]; float ss = 0.f;
#pragma unroll
  for (int i = 0; i < 8; ++i) { v[i] = s4[lane + 64 * i]; ss += v[i].x * v[i].x + v[i].y * v[i].y + v[i].z * v[i].z + v[i].w * v[i].w; }
  ss = wave_sum(ss);
  const float r = rsqrtf(ss * (1.f / 2048.f) + EPS);
#pragma unroll
  for (int i = 0; i < 8; ++i) {
    float4 gg = ((const float4*)g)[lane + 64 * i];
    uint2 o; o.x = pk2(v[i].x * r * gg.x, v[i].y * r * gg.y); o.y = pk2(v[i].z * r * gg.z, v[i].w * r * gg.w);
    *(uint2*)(dst + (lane + 64 * i) * 4) = o;
  }
}
DI void tr_tile(const float* __restrict__ src, const float* __restrict__ g, bfu* __restrict__ dst, int K, int Nsrc,
                int nvalid1, int nzero_end, int nshift, int kt, int nt, float* tile) {
  const int tid = otid();
  const int k0 = kt * 64, n0 = nt * 64;
  const int nn = (tid & 15) * 4, np = n0 + nn;
  int sn = (np < nvalid1) ? np : (np < nzero_end ? -1 : np - nshift);
  if (sn >= Nsrc) sn = -1;
#pragma unroll
  for (int i = 0; i < 4; ++i) {
    int kk = (tid >> 4) + 16 * i;
    float4 v = make_float4(0.f, 0.f, 0.f, 0.f);
    if (sn >= 0) {
      v = *(const float4*)(src + (long)(k0 + kk) * Nsrc + sn);
      if (g) { float gg = g[k0 + kk]; v.x *= gg; v.y *= gg; v.z *= gg; v.w *= gg; }
    }
    tile[kk * 65 + nn + 0] = v.x; tile[kk * 65 + nn + 1] = v.y; tile[kk * 65 + nn + 2] = v.z; tile[kk * 65 + nn + 3] = v.w;
  }
  __syncthreads();
  const int nn2 = tid >> 2, kseg = (tid & 3) * 16;
  unsigned w[8];
#pragma unroll
  for (int e = 0; e < 8; ++e) w[e] = pk2(tile[(kseg + 2 * e) * 65 + nn2], tile[(kseg + 2 * e + 1) * 65 + nn2]);
  bfu* d = dst + (long)(n0 + nn2) * K + k0 + kseg;
  *(uint4*)d = make_uint4(w[0], w[1], w[2], w[3]);
  *(uint4*)(d + 8) = make_uint4(w[4], w[5], w[6], w[7]);
  __syncthreads();
}

DI void phase0(const Params& P, char* smem) {
  char* ws = P.ws;
  const int tid = otid(), lane = tid & 63, wave = tid >> 6;
  float* tile = (float*)smem;
  if (blockIdx.x == 0 && tid < 16) ((int*)(ws + O_CTR))[tid] = 0;
  constexpr int N_XN = 4096, N_MEMN = 256;
  constexpr int T_IN = 32 * 86, T_UQ = 8 * 24, T_UKV = 8 * 32, T_C1K = 96 * 4, T_C1V = 64 * 2, T_C2K = 3 * 4, T_C2V = 2 * 2, T_MKV = 32 * 16, T_OUT = 32 * 32;
  constexpr int N_CS = 512, N_BIAS = 64;
  constexpr int S1 = N_XN, S2 = S1 + N_MEMN, S3 = S2 + T_IN, S4 = S3 + T_UQ, S5 = S4 + T_UKV, S6 = S5 + T_C1K, S7 = S6 + T_C1V,
                S8 = S7 + T_C2K, S9 = S8 + T_C2V, S10 = S9 + T_MKV, S11 = S10 + T_OUT, S12 = S11 + N_CS, S13 = S12 + N_BIAS;
  for (int it = blockIdx.x; it < S13; it += gridDim.x) {
    if (it < S1) { int row = it * 4 + wave; rms_row(P.x + (long)row * DM, P.norm_g, (bfu*)(ws + O_XN) + (long)row * DM, lane); }
    else if (it < S2) { int row = (it - S1) * 4 + wave; rms_row(P.mem + (long)row * DM, P.mem_norm_g, (bfu*)(ws + O_MEMN) + (long)row * DM, lane); }
    else if (it < S3) { int i = it - S2; tr_tile(P.w_in, nullptr, (bfu*)(ws + O_WT_IN), 2048, DIN, 3852, 3968, 116, i / 86, i % 86, tile); }
    else if (it < S4) { int i = it - S3; tr_tile(P.w_uq, P.q_norm_g, (bfu*)(ws + O_WT_UQ), 512, 1536, 1536, 1 << 30, 0, i / 24, i % 24, tile); }
    else if (it < S5) { int i = it - S4; tr_tile(P.w_ukv, P.kv_norm_g, (bfu*)(ws + O_WT_UKV), 512, 2048, 2048, 1 << 30, 0, i / 32, i % 32, tile); }
    else if (it < S6) { int i = it - S5; tr_tile(P.cmp_w1k, nullptr, (bfu*)(ws + O_WT_C1K), 6144, 192, 192, 1 << 30, 0, i / 4, i % 4, tile); }
    else if (it < S7) { int i = it - S6; tr_tile(P.cmp_w1v, nullptr, (bfu*)(ws + O_WT_C1V), 4096, 128, 128, 1 << 30, 0, i / 2, i % 2, tile); }
    else if (it < S8) { int i = it - S7; tr_tile(P.cmp_w2k, nullptr, (bfu*)(ws + O_WT_C2K), 192, 192, 192, 1 << 30, 0, i / 4, i % 4, tile); }
    else if (it < S9) { int i = it - S8; tr_tile(P.cmp_w2v, nullptr, (bfu*)(ws + O_WT_C2V), 128, 128, 128, 1 << 30, 0, i / 2, i % 2, tile); }
    else if (it < S10) { int i = it - S9; tr_tile(P.w_mem_kv, nullptr, (bfu*)(ws + O_WT_MKV), 2048, 1024, 1024, 1 << 30, 0, i / 16, i % 16, tile); }
    else if (it < S11) { int i = it - S10; tr_tile(P.w_out, nullptr, (bfu*)(ws + O_WT_OUT), 2048, 2048, 2048, 1 << 30, 0, i / 32, i % 32, tile); }
    else if (it < S12) {
      int idx = (it - S11) * 256 + tid; int pos = idx >> 5, i = idx & 31;
      float ang = (float)pos * INVF[i];
      float rev = ang * 0.15915494309189535f;
      rev = rev - floorf(rev);
      ((float*)(ws + O_COS))[idx] = __builtin_amdgcn_cosf(rev);
      ((float*)(ws + O_SIN))[idx] = __builtin_amdgcn_sinf(rev);
    }
    else {
      int i = it - S12;
      if (i < 32) { if (tid < 192) { float acc = 0.f; for (int k = i * 192; k < (i + 1) * 192; ++k) acc += P.cmp_pe_k[k] * P.cmp_w1k[(long)k * 192 + tid]; ((float*)(ws + O_BIASK))[i * 256 + tid] = acc; } }
      else { int c = i - 32; if (tid < 128) { float acc = 0.f; for (int k = c * 128; k < (c + 1) * 128; ++k) acc += P.cmp_pe_v[k] * P.cmp_w1v[(long)k * 128 + tid]; ((float*)(ws + O_BIASV))[c * 256 + tid] = acc; } }
    }
  }
}

enum { M_MLA = 0, M_MEM = 1, M_CMP1 = 2, M_CMP2 = 3, M_SLC = 4, M_WIN = 5 };
struct KVSrc { const bfu *k1, *k2, *vt; int ldk1, ldk2, ldvt; };
template <int DQK> struct KVRegs { uint4 k[DQK / 32]; uint4 v[4]; };

template <int DQK>
DI void kv_gload(KVRegs<DQK>& r, const KVSrc& s, int key0, int tid) {
  const int key = tid >> 2, kq = tid & 3;
  const unsigned o1 = (unsigned)(key0 + key) * (unsigned)s.ldk1 + kq * 8;
  const unsigned o2 = (unsigned)(key0 + key) * (unsigned)s.ldk2 + kq * 8;
#pragma unroll
  for (int i = 0; i < DQK / 32; ++i) {
    if (i < 4) r.k[i] = *(const uint4*)(s.k1 + o1 + i * 32);
    else r.k[i] = *(const uint4*)(s.k2 + o2 + (i - 4) * 32);
  }
  const unsigned ov = (unsigned)(tid >> 3) * (unsigned)s.ldvt + key0 + (tid & 7) * 8;
#pragma unroll
  for (int i = 0; i < 4; ++i) r.v[i] = *(const uint4*)(s.vt + (long)(i * 32) * s.ldvt + ov);
}
template <int DQK>
DI void kv_sstore(const KVRegs<DQK>& r, bfu* sK, bfu* sVt, int tid) {
  constexpr int LDK = DQK + 8;
  const int key = tid >> 2, kq = tid & 3;
#pragma unroll
  for (int i = 0; i < DQK / 32; ++i)
    *(uint4*)(sK + key * LDK + (kq + 4 * i) * 8) = make_uint4(r.k[i].x, r.k[i].y, r.k[i].z, r.k[i].w);
  const int kc = tid & 7;
  const int pos = 16 * (kc >> 1) + 4 * (kc & 1);
#pragma unroll
  for (int i = 0; i < 4; ++i) {
    const int d = (tid >> 3) + 32 * i;
    *(uint2*)(sVt + d * 72 + pos) = make_uint2(r.v[i].x, r.v[i].y);
    *(uint2*)(sVt + d * 72 + pos + 8) = make_uint2(r.v[i].z, r.v[i].w);
  }
}

struct LaneCtx {
  int t;
  float slope2;
  unsigned long long selmask;
  float invl;
  float carry;
  float* slab;
  int twave_min, twave_max;
};

template <int DQK, int MODE>
DI void attn_tile(const bf16x8 (&q)[DQK / 16], f32x16 (&o)[4], float& m, float& l, LaneCtx& cx, int jt, const bfu* sK, const bfu* sVt, int lane) {
  constexpr int LDK = DQK + 8;
  constexpr bool ISCMP = (MODE == M_CMP1 || MODE == M_CMP2);
  const int h = lane >> 5;
  const int key0 = jt * 64;
  bool sel = true;
  if (MODE == M_SLC) sel = (cx.selmask >> jt) & 1ull;
#pragma unroll
  for (int sub = 0; sub < 2; ++sub) {
    const int kb0 = key0 + 32 * sub;
    if (MODE == M_MLA) { if (kb0 > cx.twave_max) continue; }
    f32x16 s0;
#pragma unroll
    for (int i = 0; i < 16; ++i) s0[i] = 0.f;
    {
      const bfu* p = sK + (sub * 32 + (lane & 31)) * LDK + 8 * h;
#pragma unroll
      for (int ks = 0; ks < DQK / 16; ++ks) {
        bf16x8 a0 = *(const bf16x8*)(p + 16 * ks);
        s0 = __builtin_amdgcn_mfma_f32_32x32x16_bf16(a0, q[ks], s0, 0, 0, 0);
      }
    }
    if (MODE != M_MEM) {
      bool domask = true;
      if (MODE == M_MLA) domask = (kb0 + 31 > cx.twave_min);
      if (domask) {
        constexpr float KST = ISCMP ? 16.f : 1.f;
        const float vmax = ISCMP ? -15.5f : 0.f;
        float fd;
        if (ISCMP) fd = (float)(16 * (kb0 + 4 * h) - cx.t) + 15.5f;
        else fd = (float)(kb0 + 4 * h - cx.t);
#pragma unroll
        for (int i = 0; i < 16; ++i) {
          const float c0 = KST * (float)((i & 3) + 8 * (i >> 2));
          float d0 = fd + c0;
          bool v0 = (d0 <= vmax) && sel;
          if (MODE == M_WIN) v0 = v0 && (d0 > -512.f);
          float x0 = s0[i];
          if (MODE != M_MLA) x0 = fmaf(cx.slope2, d0, x0);
          s0[i] = v0 ? x0 : -INFINITY;
        }
      }
    }
    if (MODE == M_CMP2) {
      const float mm = m, il = cx.invl;
#pragma unroll
      for (int i = 0; i < 16; ++i) s0[i] = __builtin_amdgcn_exp2f(s0[i] - mm) * il;
      float sum4[4], recv[4];
#pragma unroll
      for (int a = 0; a < 4; ++a) sum4[a] = s0[4 * a] + s0[4 * a + 1] + s0[4 * a + 2] + s0[4 * a + 3];
      recv[0] = __shfl_xor(s0[3], 32); recv[1] = __shfl_xor(s0[7], 32); recv[2] = __shfl_xor(s0[11], 32); recv[3] = __shfl_xor(s0[15], 32);
      const float p0 = h ? recv[0] : cx.carry;
      const float p1 = h ? recv[1] : recv[0];
      const float p2 = h ? recv[2] : recv[1];
      const float p3 = h ? recv[3] : recv[2];
      cx.carry = recv[3];
      const int G = jt * 16 + sub * 8 + h;
      cx.slab[G] = sum4[0] + p0; cx.slab[G + 2] = sum4[1] + p1; cx.slab[G + 4] = sum4[2] + p2; cx.slab[G + 6] = sum4[3] + p3;
    } else {
      float mx = s0[0];
#pragma unroll
      for (int i = 1; i < 16; ++i) mx = fmaxf(mx, s0[i]);
      mx = xhalf_max(mx);
      const float mn = fmaxf(m, mx);
      const float alpha = __builtin_amdgcn_exp2f(m - mn);
      m = mn;
      float ps = 0.f;
#pragma unroll
      for (int i = 0; i < 16; ++i) { s0[i] = __builtin_amdgcn_exp2f(s0[i] - mn); ps += s0[i]; }
      l = l * alpha + ps;
      if (MODE != M_CMP1) {
        if (!__all(alpha == 1.f)) {
#pragma unroll
          for (int dt = 0; dt < 4; ++dt)
#pragma unroll
            for (int i = 0; i < 16; ++i) o[dt][i] *= alpha;
        }
      }
    }
    if (MODE != M_CMP1) {
      const bfu* p = sVt + (lane & 31) * 72 + 8 * h + 32 * sub;
#pragma unroll
      for (int s2 = 0; s2 < 2; ++s2) {
        const int bs = 8 * s2;
        u32x4 w;
        w[0] = pk2(s0[bs], s0[bs + 1]); w[1] = pk2(s0[bs + 2], s0[bs + 3]); w[2] = pk2(s0[bs + 4], s0[bs + 5]); w[3] = pk2(s0[bs + 6], s0[bs + 7]);
        bf16x8 pb = __builtin_bit_cast(bf16x8, w);
#pragma unroll
        for (int dt = 0; dt < 4; ++dt) {
          bf16x8 a = *(const bf16x8*)(p + dt * 32 * 72 + 16 * s2);
          o[dt] = __builtin_amdgcn_mfma_f32_32x32x16_bf16(a, pb, o[dt], 0, 0, 0);
        }
      }
    }
  }
}

template <int DQK, int MODE>
DI void flash(const bf16x8 (&q)[DQK / 16], f32x16 (&o)[4], float& m, float& l, LaneCtx& cx, const KVSrc& src,
              unsigned long long tilemask, bfu* sK, bfu* sVt) {
  const int tid = otid(), lane = tid & 63;
  unsigned lo = __builtin_amdgcn_readfirstlane((unsigned)tilemask), hi = __builtin_amdgcn_readfirstlane((unsigned)(tilemask >> 32));
  unsigned long long rem = ((unsigned long long)hi << 32) | lo;
  if (rem == 0ull) return;
  int j = __builtin_ctzll(rem); rem &= rem - 1;
  KVRegs<DQK> r;
  kv_gload<DQK>(r, src, j * 64, tid);
  kv_sstore<DQK>(r, sK, sVt, tid);
  __syncthreads();
  while (true) {
    int jn = -1;
    if (rem != 0ull) { jn = __builtin_ctzll(rem); rem &= rem - 1; kv_gload<DQK>(r, src, jn * 64, tid); }
    attn_tile<DQK, MODE>(q, o, m, l, cx, j, sK, sVt, lane);
    __syncthreads();
    if (jn < 0) break;
    kv_sstore<DQK>(r, sK, sVt, tid);
    __syncthreads();
    j = jn;
  }
}

DI unsigned long long bits_upto(int n) { return n >= 64 ? ~0ull : ((1ull << n) - 1ull); }

template <int DQK>
DI void load_q(bf16x8 (&q)[DQK / 16], const bfu* Q, long ldq, int lane) {
  const bfu* p = Q + (long)(lane & 31) * ldq + 8 * (lane >> 5);
#pragma unroll
  for (int ks = 0; ks < DQK / 16; ++ks) q[ks] = *(const bf16x8*)(p + 16 * ks);
}

DI void store_gated(const f32x16 (&o)[4], float sc, const bfu* zs, bfu* dst, int h) {
#pragma unroll
  for (int dt = 0; dt < 4; ++dt)
#pragma unroll
    for (int g = 0; g < 4; ++g) {
      int d = 32 * dt + 8 * g + 4 * h;
      uint2 z = *(const uint2*)(zs + d);
      uint2 w;
      w.x = pk2(o[dt][4 * g] * sc * blo(z.x), o[dt][4 * g + 1] * sc * bhi(z.x));
      w.y = pk2(o[dt][4 * g + 2] * sc * blo(z.y), o[dt][4 * g + 3] * sc * bhi(z.y));
      *(uint2*)(dst + d) = w;
    }
}

DI void mla_item(const Params& P, int b, int head, int qt, char* smem) {
  char* ws = P.ws;
  bfu* sK = (bfu*)smem; bfu* sVt = (bfu*)(smem + 25600);
  const int tid = otid(), lane = tid & 63, wave = tid >> 6, h = lane >> 5, ql = lane & 31;
  const int tq0 = qt * 128 + wave * 32;
  const long tok0 = (long)b * SEQ + tq0;
  bf16x8 q[12];
  load_q<192>(q, (const bfu*)(ws + O_QMLA) + tok0 * 1536 + head * 192, 1536, lane);
  KVSrc src;
  src.k1 = (const bfu*)(ws + O_KNOPE) + (long)b * SEQ * 1024 + head * 128; src.ldk1 = 1024;
  src.k2 = (const bfu*)(ws + O_KPE) + (long)b * SEQ * 64; src.ldk2 = 64;
  src.vt = (const bfu*)(ws + O_VMLAT) + (long)(b * 8 + head) * 128 * SEQ; src.ldvt = SEQ;
  LaneCtx cx; cx.t = tq0 + ql; cx.slope2 = 0.f; cx.selmask = 0; cx.invl = 0.f; cx.carry = 0.f; cx.slab = nullptr; cx.twave_min = tq0; cx.twave_max = tq0 + 31;
  f32x16 o[4];
#pragma unroll
  for (int dt = 0; dt < 4; ++dt)
#pragma unroll
    for (int i = 0; i < 16; ++i) o[dt][i] = 0.f;
  float m = -1e30f, l = 0.f;
  flash<192, M_MLA>(q, o, m, l, cx, src, bits_upto(2 * (qt + 1)), sK, sVt);
  const float lt = xhalf_sum(l);
  const float sc = 1.f / (lt + 1e-20f);
  const long tok = tok0 + ql;
  store_gated(o, sc, (const bfu*)(ws + O_ZS) + tok * 2048 + head * 128, (bfu*)(ws + O_OCAT) + tok * 2048 + head * 128, h);
}

DI void mem_item(const Params& P, int b, int head, int qt, char* smem) {
  char* ws = P.ws;
  bfu* sK = (bfu*)smem; bfu* sVt = (bfu*)(smem + 25600);
  const int tid = otid(), lane = tid & 63, wave = tid >> 6, h = lane >> 5, ql = lane & 31;
  const int tq0 = qt * 128 + wave * 32;
  const long tok0 = (long)b * SEQ + tq0;
  bf16x8 q[8];
  load_q<128>(q, (const bfu*)(ws + O_QMEM) + tok0 * 512 + head * 128, 512, lane);
  KVSrc src;
  src.k1 = (const bfu*)(ws + O_MEMK) + (long)b * 256 * 512 + head * 128; src.ldk1 = 512;
  src.k2 = src.k1; src.ldk2 = 512;
  src.vt = (const bfu*)(ws + O_MEMVT) + (long)(b * 4 + head) * 128 * 256; src.ldvt = 256;
  LaneCtx cx; cx.t = 0; cx.slope2 = 0.f; cx.selmask = 0; cx.invl = 0.f; cx.carry = 0.f; cx.slab = nullptr; cx.twave_min = 0; cx.twave_max = 0;
  f32x16 o[4];
#pragma unroll
  for (int dt = 0; dt < 4; ++dt)
#pragma unroll
    for (int i = 0; i < 16; ++i) o[dt][i] = 0.f;
  float m = -1e30f, l = 0.f;
  flash<128, M_MEM>(q, o, m, l, cx, src, 0xFull, sK, sVt);
  const float lt = xhalf_sum(l);
  const float sc = 1.f / lt;
  const long tok = tok0 + ql;
  store_gated(o, sc, (const bfu*)(ws + O_ZS) + tok * 2048 + 1536 + head * 128, (bfu*)(ws + O_OCAT) + tok * 2048 + 1536 + head * 128, h);
}

DI void onsa_acc(const f32x16 (&o)[4], float sc, float* dst, int h, bool add) {
#pragma unroll
  for (int dt = 0; dt < 4; ++dt)
#pragma unroll
    for (int g = 0; g < 4; ++g) {
      int d = 32 * dt + 8 * g + 4 * h;
      float4 v = make_float4(o[dt][4 * g] * sc, o[dt][4 * g + 1] * sc, o[dt][4 * g + 2] * sc, o[dt][4 * g + 3] * sc);
      if (add) { float4 p = *(const float4*)(dst + d); v.x += p.x; v.y += p.y; v.z += p.z; v.w += p.w; }
      *(float4*)(dst + d) = v;
    }
}

DI void nsa_item(const Params& P, int b, int qt, char* smem) {
  char* ws = P.ws;
  bfu* sK = (bfu*)smem; bfu* sVt = (bfu*)(smem + 25600);
  float* slab = (float*)(smem + 45056);
  unsigned long long* selm = (unsigned long long*)(smem + 77824);
  const int tid = otid(), lane = tid & 63, wave = tid >> 6, h = lane >> 5, ql = lane & 31;
  const int head = wave;
  const int t0 = qt * 32;
  const long tok0 = (long)b * SEQ + t0;
  const long tok = tok0 + ql;
  bf16x8 q[12];
  load_q<192>(q, (const bfu*)(ws + O_QNSA) + tok0 * 768 + head * 192, 768, lane);
  const float* gp = (const float*)(ws + O_GATES) + tok * 16 + head * 3;
  const float g0 = gp[0], g1 = gp[1], g2 = gp[2];
  float* onsa = (float*)(ws + O_ONSA) + tok * 512 + head * 128;
  LaneCtx cx; cx.t = t0 + ql; cx.slope2 = exp2f(-2.f * (float)(head + 1)) * LOG2E; cx.selmask = 0; cx.invl = 0.f; cx.carry = 0.f;
  cx.slab = slab + (wave * 32 + ql) * 64; cx.twave_min = t0; cx.twave_max = t0 + 31;
#pragma unroll
  for (int i = 0; i < 32; ++i) slab[tid + 256 * i] = 0.f;
  __syncthreads();
  f32x16 o[4];
  float m, l;
  {
    KVSrc src;
    src.k1 = (const bfu*)(ws + O_KCMP) + (long)b * 256 * 192; src.ldk1 = 192;
    src.k2 = src.k1 + 128; src.ldk2 = 192;
    src.vt = (const bfu*)(ws + O_VCMPT) + (long)b * 128 * 256; src.ldvt = 256;
    const int ntc = ((t0 >> 4) >> 6) + 1;
    m = -1e30f; l = 0.f;
    flash<192, M_CMP1>(q, o, m, l, cx, src, bits_upto(ntc), sK, sVt);
    const float lt = xhalf_sum(l);
    cx.invl = 1.f / (lt + 1e-20f);
#pragma unroll
    for (int dt = 0; dt < 4; ++dt)
#pragma unroll
      for (int i = 0; i < 16; ++i) o[dt][i] = 0.f;
    flash<192, M_CMP2>(q, o, m, l, cx, src, bits_upto(ntc), sK, sVt);
    onsa_acc(o, g0, onsa, h, false);
  }
  __syncthreads();
  const int cur = t0 >> 6;
  for (int qi = 0; qi < 8; ++qi) {
    const int qq = wave * 8 + qi;
    float v = slab[(0 * 32 + qq) * 64 + lane] + slab[(1 * 32 + qq) * 64 + lane] + slab[(2 * 32 + qq) * 64 + lane] + slab[(3 * 32 + qq) * 64 + lane];
    const bool forced = (lane == 0) || (lane == cur) || (lane == cur - 1);
    if (forced) v = 1e9f;
    if (lane > cur) v = -1e9f;
    int rank = 0;
#pragma unroll
    for (int j = 0; j < 64; ++j) {
      float vj = __builtin_bit_cast(float, __builtin_amdgcn_readlane(__builtin_bit_cast(int, v), j));
      rank += ((vj > v) || (vj == v && j < lane)) ? 1 : 0;
    }
    unsigned long long msk = __ballot(rank < 16);
    if (lane == 0) selm[qq] = msk;
  }
  __syncthreads();
  {
    const unsigned long long mym = selm[ql];
    unsigned ulo = (unsigned)mym, uhi = (unsigned)(mym >> 32);
#pragma unroll
    for (int off = 16; off >= 1; off >>= 1) { ulo |= __shfl_xor(ulo, off); uhi |= __shfl_xor(uhi, off); }
    unsigned long long uni = (((unsigned long long)uhi) << 32) | ulo;
    uni &= bits_upto(cur + 1);
    cx.selmask = mym;
    KVSrc src;
    src.k1 = (const bfu*)(ws + O_KS) + (long)b * SEQ * 192; src.ldk1 = 192;
    src.k2 = src.k1 + 128; src.ldk2 = 192;
    src.vt = (const bfu*)(ws + O_VST) + (long)b * 128 * SEQ; src.ldvt = SEQ;
    m = -1e30f; l = 0.f;
#pragma unroll
    for (int dt = 0; dt < 4; ++dt)
#pragma unroll
      for (int i = 0; i < 16; ++i) o[dt][i] = 0.f;
    flash<192, M_SLC>(q, o, m, l, cx, src, uni, sK, sVt);
    const float lt = xhalf_sum(l);
    onsa_acc(o, g1 / (lt + 1e-20f), onsa, h, true);
  }
  {
    KVSrc src;
    src.k1 = (const bfu*)(ws + O_KW) + (long)b * SEQ * 192; src.ldk1 = 192;
    src.k2 = src.k1 + 128; src.ldk2 = 192;
    src.vt = (const bfu*)(ws + O_VWT) + (long)b * 128 * SEQ; src.ldvt = SEQ;
    int lo_t = t0 - 511; if (lo_t < 0) lo_t = 0;
    const int j0 = lo_t >> 6, j1 = (t0 + 31) >> 6;
    unsigned long long tm = bits_upto(j1 + 1) & ~bits_upto(j0);
    m = -1e30f; l = 0.f;
#pragma unroll
    for (int dt = 0; dt < 4; ++dt)
#pragma unroll
      for (int i = 0; i < 16; ++i) o[dt][i] = 0.f;
    flash<192, M_WIN>(q, o, m, l, cx, src, tm, sK, sVt);
    const float lt = xhalf_sum(l);
    const float sc = g2 / (lt + 1e-20f);
    const bfu* zs = (const bfu*)(ws + O_ZS) + tok * 2048 + 1024 + head * 128;
    bfu* dst = (bfu*)(ws + O_OCAT) + tok * 2048 + 1024 + head * 128;
#pragma unroll
    for (int dt = 0; dt < 4; ++dt)
#pragma unroll
      for (int g = 0; g < 4; ++g) {
        int d = 32 * dt + 8 * g + 4 * h;
        float4 p = *(const float4*)(onsa + d);
        uint2 z = *(const uint2*)(zs + d);
        uint2 w;
        w.x = pk2((p.x + o[dt][4 * g] * sc) * blo(z.x), (p.y + o[dt][4 * g + 1] * sc) * bhi(z.x));
        w.y = pk2((p.z + o[dt][4 * g + 2] * sc) * blo(z.y), (p.w + o[dt][4 * g + 3] * sc) * bhi(z.y));
        *(uint2*)(dst + d) = w;
      }
  }
}

__global__ void __launch_bounds__(256, 2) mega(Params P) {
  extern __shared__ __attribute__((aligned(16))) char smem[];
  cg::grid_group grid = cg::this_grid();
  char* ws = P.ws;
  const int tid = otid();
#define RUNPH(n) (P.phase_lo <= (n) && (n) <= P.phase_hi)
#define SYNCPH(n) if (P.phase_lo <= (n) && (n) < P.phase_hi) grid.sync();
  {
    if (RUNPH(0)) {
      phase0(P, smem);
    }
    SYNCPH(0)
    if (RUNPH(1)) {
      constexpr int T1 = 128 * 43, T2 = 8 * 8;
      for (int it = blockIdx.x; it < T1 + T2; it += gridDim.x) {
        if (it < T1) { int mt = it / 43, nt = it % 43; EpiInProj e{ws};
          gemm_tile<false>((const bfu*)(ws + O_XN), 2048, (const bfu*)(ws + O_WT_IN), 2048, 2048, mt * 128, nt * 128, e, smem); }
        else { int i = it - T1; EpiMemKV e{ws};
          gemm_tile<false>((const bfu*)(ws + O_MEMN), 2048, (const bfu*)(ws + O_WT_MKV), 2048, 2048, (i >> 3) * 128, (i & 7) * 128, e, smem); }
      }
    }
    SYNCPH(1)
    if (RUNPH(2)) {
      constexpr int A1 = 16, A2 = A1 + 8, A3 = A2 + 128 * 16, A4 = A3 + 128 * 12;
      for (int it = blockIdx.x; it < A4; it += gridDim.x) {
        if (it < A1) { EpiC1 e{(const float*)(ws + O_BIASK), (bfu*)(ws + O_H1K), 192};
          gemm_tile<false>((const bfu*)(ws + O_KC), 3072, (const bfu*)(ws + O_WT_C1K), 6144, 6144, (it >> 1) * 128, (it & 1) * 128, e, smem); }
        else if (it < A2) { int i = it - A1; EpiC1 e{(const float*)(ws + O_BIASV), (bfu*)(ws + O_H1V), 128};
          gemm_tile<false>((const bfu*)(ws + O_VC), 2048, (const bfu*)(ws + O_WT_C1V), 4096, 4096, i * 128, 0, e, smem); }
        else if (it < A3) { int i = it - A2; EpiUKV e{ws};
          gemm_tile<true>((const bfu*)(ws + O_CKV), 512, (const bfu*)(ws + O_WT_UKV), 512, 512, (i >> 4) * 128, (i & 15) * 128, e, smem); }
        else { int i = it - A3; EpiUQ e{ws};
          gemm_tile<true>((const bfu*)(ws + O_CQ), 512, (const bfu*)(ws + O_WT_UQ), 512, 512, (i / 12) * 128, (i % 12) * 128, e, smem); }
      }
    }
    SYNCPH(2)
    if (RUNPH(3)) {
      for (int it = blockIdx.x; it < 24; it += gridDim.x) {
        if (it < 16) { EpiC2K e{ws};
          gemm_tile<false>((const bfu*)(ws + O_H1K), 192, (const bfu*)(ws + O_WT_C2K), 192, 192, (it >> 1) * 128, (it & 1) * 128, e, smem); }
        else { int i = it - 16; EpiC2V e{ws};
          gemm_tile<false>((const bfu*)(ws + O_H1V), 128, (const bfu*)(ws + O_WT_C2V), 128, 128, i * 128, 0, e, smem); }
      }
    }
    SYNCPH(3)
    if (RUNPH(4)) {
      int* ctr = (int*)(ws + O_CTR);
      int* s_item = (int*)(smem + SMEM_BYTES - 16);
      while (true) {
        if (tid == 0) *s_item = atomicAdd(ctr, 1);
        __syncthreads();
        const int it = *s_item;
        __syncthreads();
        if (it >= 2048) break;
        if (it < 512 || (it >= 1024 && it < 1536)) { int i = (it < 512) ? it : it - 512; int qt = 31 - (i >> 5), bh = i & 31; mla_item(P, bh >> 3, bh & 7, qt, smem); }
        else if (it < 1024) { int i = it - 512; nsa_item(P, i & 3, 127 - (i >> 2), smem); }
        else { int i = it - 1536; mem_item(P, i >> 7, (i >> 5) & 3, i & 31, smem); }
      }
    }
    SYNCPH(4)
    if (RUNPH(5)) {
      EpiOut e{P.x, P.out, (float*)(ws + O_SSQP)};
      for (int it = blockIdx.x; it < 128 * 16; it += gridDim.x)
        gemm_tile<false>((const bfu*)(ws + O_OCAT), 2048, (const bfu*)(ws + O_WT_OUT), 2048, 2048, (it >> 4) * 128, (it & 15) * 128, e, smem);
    }
    SYNCPH(5)
    if (RUNPH(6)) {
      const int lane = tid & 63, wave = tid >> 6;
      const float* sp = (const float*)(ws + O_SSQP);
      for (int it = blockIdx.x; it < NTOK / 4; it += gridDim.x) {
        const int row = it * 4 + wave;
        float s = (lane < 32) ? sp[(long)row * 32 + lane] : 0.f;
        s = wave_sum(s);
        const float r = rsqrtf(s * (1.f / 2048.f) + EPS);
        float4* o4 = (float4*)(P.out + (long)row * DM);
#pragma unroll
        for (int i = 0; i < 8; ++i) {
          float4 v = o4[lane + 64 * i]; float4 g = ((const float4*)P.final_g)[lane + 64 * i];
          v.x *= r * g.x; v.y *= r * g.y; v.z *= r * g.z; v.w *= r * g.w;
          o4[lane + 64 * i] = v;
        }
      }
    }
  }
}

extern "C" void kernel_launch(void* const* d_in, const int* in_sizes, int n_in, void* d_out, int out_size, void* d_ws, size_t ws_size,
                              hipStream_t stream) {
  static int grid_blocks = 0;
  if (!grid_blocks) {
    int dev = 0, cus = 0, per_cu = 0;
    hipGetDevice(&dev);
    hipDeviceGetAttribute(&cus, hipDeviceAttributeMultiprocessorCount, dev);
    hipFuncSetAttribute((const void*)mega, hipFuncAttributeMaxDynamicSharedMemorySize, SMEM_BYTES);
    hipOccupancyMaxActiveBlocksPerMultiprocessor(&per_cu, mega, 256, SMEM_BYTES);
    if (per_cu < 1) per_cu = 1;
    if (per_cu > 2) per_cu = 2;
    grid_blocks = cus * per_cu;
    if (ws_size < WS_TOTAL) fprintf(stderr, "workspace too small: %zu < %zu\n", ws_size, (size_t)WS_TOTAL);
  }
  Params p{};
  p.x = (const float*)d_in[0]; p.mem = (const float*)d_in[1]; p.norm_g = (const float*)d_in[2]; p.w_in = (const float*)d_in[3];
  p.q_norm_g = (const float*)d_in[4]; p.w_uq = (const float*)d_in[5]; p.kv_norm_g = (const float*)d_in[6]; p.w_ukv = (const float*)d_in[7];
  p.cmp_pe_k = (const float*)d_in[8]; p.cmp_pe_v = (const float*)d_in[9]; p.cmp_w1k = (const float*)d_in[10]; p.cmp_w2k = (const float*)d_in[11];
  p.cmp_w1v = (const float*)d_in[12]; p.cmp_w2v = (const float*)d_in[13]; p.mem_norm_g = (const float*)d_in[14]; p.w_mem_kv = (const float*)d_in[15];
  p.w_out = (const float*)d_in[16]; p.final_g = (const float*)d_in[17];
  p.out = (float*)d_out; p.ws = (char*)d_ws;
#if MULTI_LAUNCH
  for (int ph = 0; ph <= 6; ++ph) {
    p.phase_lo = ph; p.phase_hi = ph;
    hipLaunchKernelGGL(mega, dim3(grid_blocks), dim3(256), SMEM_BYTES, stream, p);
  }
#else
  p.phase_lo = 0; p.phase_hi = 6;
  void* args[] = {&p};
  hipError_t e = hipLaunchCooperativeKernel((void*)mega, dim3(grid_blocks), dim3(256), args, SMEM_BYTES, stream);
  if (e != hipSuccess) fprintf(stderr, "cooperative launch failed: %s (grid %d)\n", hipGetErrorString(e), grid_blocks);
#endif
}
```

```cpp
#include <hip/hip_runtime.h>
#include <hip/hip_cooperative_groups.h>
#include <stdint.h>
#include <cstdio>
namespace cg = cooperative_groups;

typedef unsigned short bfu;
typedef __attribute__((ext_vector_type(8))) short bf16x8;
typedef __attribute__((ext_vector_type(4))) float f32x4;
typedef __attribute__((ext_vector_type(16))) float f32x16;
typedef __attribute__((ext_vector_type(2))) __bf16 bf2_t;
typedef __attribute__((ext_vector_type(4))) unsigned u32x4;
#define DI __device__ __forceinline__

#ifndef DUP_PHASE
#define DUP_PHASE -1
#endif
#ifndef MULTI_LAUNCH
#define MULTI_LAUNCH 0
#endif

constexpr int SEQ = 4096, NTOK = 16384, DM = 2048, DIN = 5388, DINP = 5504;
constexpr float EPS = 1e-6f;
constexpr float LOG2E = 1.4426950408889634f;
constexpr int SMEM_BYTES = 81920;

constexpr size_t al(size_t x) { return (x + 255) & ~size_t(255); }
constexpr size_t O_WT_IN  = 0;
constexpr size_t O_WT_UQ  = O_WT_IN  + al((size_t)DINP * 2048 * 2);
constexpr size_t O_WT_UKV = O_WT_UQ  + al((size_t)1536 * 512 * 2);
constexpr size_t O_WT_C1K = O_WT_UKV + al((size_t)2048 * 512 * 2);
constexpr size_t O_WT_C1V = O_WT_C1K + al((size_t)256 * 6144 * 2);
constexpr size_t O_WT_C2K = O_WT_C1V + al((size_t)128 * 4096 * 2);
constexpr size_t O_WT_C2V = O_WT_C2K + al((size_t)256 * 192 * 2);
constexpr size_t O_WT_MKV = O_WT_C2V + al((size_t)128 * 128 * 2);
constexpr size_t O_WT_OUT = O_WT_MKV + al((size_t)1024 * 2048 * 2);
constexpr size_t O_BIASK  = O_WT_OUT + al((size_t)2048 * 2048 * 2);
constexpr size_t O_BIASV  = O_BIASK  + al((size_t)32 * 256 * 4);
constexpr size_t O_COS    = O_BIASV  + al((size_t)32 * 256 * 4);
constexpr size_t O_SIN    = O_COS    + al((size_t)4096 * 32 * 4);
constexpr size_t O_XN     = O_SIN    + al((size_t)4096 * 32 * 4);
constexpr size_t O_MEMN   = O_XN     + al((size_t)NTOK * 2048 * 2);
constexpr size_t O_CQ     = O_MEMN   + al((size_t)1024 * 2048 * 2);
constexpr size_t O_CKV    = O_CQ     + al((size_t)NTOK * 512 * 2);
constexpr size_t O_KPE    = O_CKV    + al((size_t)NTOK * 512 * 2);
constexpr size_t O_ZS     = O_KPE    + al((size_t)NTOK * 64 * 2);
constexpr size_t O_QNSA   = O_ZS     + al((size_t)NTOK * 2048 * 2);
constexpr size_t O_KC     = O_QNSA   + al((size_t)NTOK * 768 * 2);
constexpr size_t O_VC     = O_KC     + al((size_t)(NTOK + 64) * 192 * 2);
constexpr size_t O_KS     = O_VC     + al((size_t)(NTOK + 64) * 128 * 2);
constexpr size_t O_VST    = O_KS     + al((size_t)NTOK * 192 * 2);
constexpr size_t O_KW     = O_VST    + al((size_t)NTOK * 128 * 2);
constexpr size_t O_VWT    = O_KW     + al((size_t)NTOK * 192 * 2);
constexpr size_t O_GATES  = O_VWT    + al((size_t)NTOK * 128 * 2);
constexpr size_t O_QMEM   = O_GATES  + al((size_t)NTOK * 16 * 4);
constexpr size_t O_QMLA   = O_QMEM   + al((size_t)NTOK * 512 * 2);
constexpr size_t O_KNOPE  = O_QMLA   + al((size_t)NTOK * 1536 * 2);
constexpr size_t O_VMLAT  = O_KNOPE  + al((size_t)NTOK * 1024 * 2);
constexpr size_t O_H1K    = O_VMLAT  + al((size_t)NTOK * 1024 * 2);
constexpr size_t O_H1V    = O_H1K    + al((size_t)1024 * 192 * 2);
constexpr size_t O_KCMP   = O_H1V    + al((size_t)1024 * 128 * 2);
constexpr size_t O_VCMPT  = O_KCMP   + al((size_t)1024 * 192 * 2);
constexpr size_t O_MEMK   = O_VCMPT  + al((size_t)1024 * 128 * 2);
constexpr size_t O_MEMVT  = O_MEMK   + al((size_t)1024 * 512 * 2);
constexpr size_t O_OCAT   = O_MEMVT  + al((size_t)1024 * 512 * 2);
constexpr size_t O_ONSA   = O_OCAT   + al((size_t)NTOK * 2048 * 2);
constexpr size_t O_SSQP   = O_ONSA   + al((size_t)NTOK * 512 * 4);
constexpr size_t O_PARTK  = O_SSQP   + al((size_t)NTOK * 32 * 4);
constexpr size_t O_PARTV  = O_PARTK  + al((size_t)8 * 1024 * 256 * 4);
constexpr size_t O_CTR    = O_PARTV  + al((size_t)8 * 1024 * 128 * 4);
constexpr size_t CTR_BYTES = 16384 + 4096;
constexpr size_t O_Q      = O_CTR + 16384;
constexpr size_t WS_TOTAL = O_CTR    + CTR_BYTES;

struct Params {
  const float *x, *mem, *norm_g, *w_in, *q_norm_g, *w_uq, *kv_norm_g, *w_ukv, *cmp_pe_k, *cmp_pe_v,
              *cmp_w1k, *cmp_w2k, *cmp_w1v, *cmp_w2v, *mem_norm_g, *w_mem_kv, *w_out, *final_g;
  float* out;
  char* ws;
  int phase_lo, phase_hi;
};

__constant__ float INVF[32] = {1.000000000e+00f, 7.498942093e-01f, 5.623413252e-01f, 4.216965034e-01f, 3.162277660e-01f, 2.371373706e-01f, 1.778279410e-01f, 1.333521432e-01f, 1.000000000e-01f, 7.498942093e-02f, 5.623413252e-02f, 4.216965034e-02f, 3.162277660e-02f, 2.371373706e-02f, 1.778279410e-02f, 1.333521432e-02f, 1.000000000e-02f, 7.498942093e-03f, 5.623413252e-03f, 4.216965034e-03f, 3.162277660e-03f, 2.371373706e-03f, 1.778279410e-03f, 1.333521432e-03f, 1.000000000e-03f, 7.498942093e-04f, 5.623413252e-04f, 4.216965034e-04f, 3.162277660e-04f, 2.371373706e-04f, 1.778279410e-04f, 1.333521432e-04f};

DI unsigned pk2(float a, float b) { bf2_t v; v[0] = (__bf16)a; v[1] = (__bf16)b; return __builtin_bit_cast(unsigned, v); }
DI bfu f2b(float a) { return __builtin_bit_cast(unsigned short, (__bf16)a); }
DI float b2f(bfu v) { return __uint_as_float(((unsigned)v) << 16); }
DI float blo(unsigned v) { return __uint_as_float(v << 16); }
DI float bhi(unsigned v) { return __uint_as_float(v & 0xffff0000u); }
DI float siluf(float z) { return z * __builtin_amdgcn_rcpf(1.f + __expf(-z)); }
DI int otid() { int t = threadIdx.x; asm volatile("" : "+v"(t)); return t; }
DI float wave_sum(float v) {
#pragma unroll
  for (int o = 32; o >= 1; o >>= 1) v += __shfl_xor(v, o);
  return v;
}
DI float xhalf_max(float v) {
  auto rr = __builtin_amdgcn_permlane32_swap(__float_as_uint(v), __float_as_uint(v), false, false);
  return fmaxf(__uint_as_float(rr[0]), __uint_as_float(rr[1]));
}
DI float xhalf_sum(float v) {
  auto rr = __builtin_amdgcn_permlane32_swap(__float_as_uint(v), __float_as_uint(v), false, false);
  return __uint_as_float(rr[0]) + __uint_as_float(rr[1]);
}


#define XB_TMO      128
#define XB_XCNT(j)  (256  + 64 * (j))
#define XB_XSUB(j)  (1280 + 64 * (j))
#define XB_XGEN(j)  (2304 + 64 * (j))
#define XB_TOP      3328
#define XB_TOPGEN   3392
#define XCD_BAR_WORDS 3456
#define XB_SPIN_CAP (1u << 18)
#define LAS __attribute__((address_space(3)))
DI unsigned xb_ld(unsigned* p)              { return __hip_atomic_load(p, __ATOMIC_RELAXED, __HIP_MEMORY_SCOPE_AGENT); }
DI unsigned xb_add(unsigned* p, unsigned v) { return __hip_atomic_fetch_add(p, v, __ATOMIC_RELAXED, __HIP_MEMORY_SCOPE_AGENT); }
DI unsigned xb_xcc_id() { return (unsigned)__builtin_amdgcn_s_getreg((3 << 11) | 20) & 0xFu; }
#define XB_SPIN(cond, bar) do { unsigned _sp = 0; while (cond) { __builtin_amdgcn_s_sleep(1); \
    if ((++_sp & 255u) == 0u) { if (xb_ld(&(bar)[XB_TMO])) break; if (_sp > XB_SPIN_CAP) { atomicAdd(&(bar)[XB_TMO], 1u); break; } } } } while (0)
struct XcdBarrier { unsigned* bar; unsigned x; volatile LAS unsigned* st; };
DI XcdBarrier xcd_barrier_post(unsigned* bar, volatile LAS unsigned* st) {
  XcdBarrier b; b.bar = bar; b.x = xb_xcc_id(); b.st = st;
  if (threadIdx.x == 0) (void)xb_add(&bar[XB_XCNT(b.x)], 1u);
  return b;
}
DI void xcd_barrier_complete(unsigned* bar, unsigned x, unsigned& nloc, unsigned& nx) {
  const unsigned G = gridDim.x * gridDim.y * gridDim.z;
  unsigned sum, cnt, mine, sp = 0u;
  for (;;) {
    sum = 0u; cnt = 0u; mine = 0u;
#pragma unroll
    for (unsigned j = 0; j < 16; ++j) { const unsigned c = xb_ld(&bar[XB_XCNT(j)]); sum += c; cnt += (c > 0u) ? 1u : 0u; mine = (j == x) ? c : mine; }
    if (sum == G) break;
    __builtin_amdgcn_s_sleep(1);
    if ((++sp & 255u) == 0u) { if (xb_ld(&bar[XB_TMO])) break; if (sp > XB_SPIN_CAP) { atomicAdd(&bar[XB_TMO], 1u); break; } }
  }
  nloc = mine > 0u ? mine : 1u; nx = cnt > 0u ? cnt : 1u;
}
DI void xcd_barrier(const XcdBarrier& b) {
  asm volatile("s_waitcnt vmcnt(0)" ::: "memory");
  __syncthreads();
  if (threadIdx.x == 0) {
    unsigned* bar = b.bar;
    __builtin_amdgcn_s_waitcnt(0);
    unsigned nloc = b.st[0], nx = b.st[1];
    if (nloc == 0u) { xcd_barrier_complete(bar, b.x, nloc, nx); b.st[0] = nloc; b.st[1] = nx; }
    const unsigned old = xb_add(&bar[XB_XSUB(b.x)], 1u);
    const unsigned gen = old / nloc;
    if (old + 1u == (gen + 1u) * nloc) {
      __builtin_amdgcn_fence(__ATOMIC_RELEASE, "agent");
      asm volatile("s_waitcnt vmcnt(0)" ::: "memory");
      const unsigned og = xb_add(&bar[XB_TOP], 1u);
      const unsigned tg = og / nx;
      if (og + 1u == (tg + 1u) * nx) xb_add(&bar[XB_TOPGEN], 1u);
      else XB_SPIN(xb_ld(&bar[XB_TOPGEN]) == tg, bar);
      __builtin_amdgcn_fence(__ATOMIC_ACQUIRE, "agent");
      xb_add(&bar[XB_XGEN(b.x)], 1u);
      asm volatile("s_waitcnt vmcnt(0)" ::: "memory");
    } else {
      XB_SPIN(xb_ld(&bar[XB_XGEN(b.x)]) == gen, bar);
      __builtin_amdgcn_fence(__ATOMIC_ACQUIRE, "agent");
      asm volatile("s_waitcnt vmcnt(0)" ::: "memory");
    }
  }
  __syncthreads();
}
DI int q_pull(unsigned* q, int per, int& cur, int& tried, int* s_item, int tid) {
  if (tid == 0) {
    int r = -1;
    while (tried < 8) {
      unsigned v = atomicAdd(&q[cur * 16], 1u);
      if (v < (unsigned)per) { r = (cur << 20) | (int)v; break; }
      cur = (cur + 1) & 7; ++tried;
    }
    *s_item = r;
  }
  __syncthreads();
  const int r = *s_item;
  __syncthreads();
  return r;
}


DI uint4 psum_load(const float* part, int N, int row, int k) {
  float v[8] = {0.f, 0.f, 0.f, 0.f, 0.f, 0.f, 0.f, 0.f};
#pragma unroll
  for (int c = 0; c < 8; ++c) {
    const float4* p = (const float4*)(part + ((long)c * 1024 + row) * N + k);
    float4 a = p[0], b = p[1];
    v[0] += a.x; v[1] += a.y; v[2] += a.z; v[3] += a.w; v[4] += b.x; v[5] += b.y; v[6] += b.z; v[7] += b.w;
  }
  return make_uint4(pk2(siluf(v[0]), siluf(v[1])), pk2(siluf(v[2]), siluf(v[3])), pk2(siluf(v[4]), siluf(v[5])), pk2(siluf(v[6]), siluf(v[7])));
}
constexpr int G_LD = 72;
template <bool SSQ, bool PSUM, class Epi>
DI void gemm_tile(const bfu* __restrict__ A, long lda, const bfu* __restrict__ Bt, long ldb, int K, int row0, int col0,
                  const Epi& epi, char* smem) {
  bfu* sA = (bfu*)smem;
  bfu* sB = sA + 2 * 128 * G_LD;
  float* rs = (float*)(sB + 2 * 128 * G_LD);
  const int tid = otid(), lane = tid & 63, wave = tid >> 6;
  const int wm = wave >> 1, wn = wave & 1, l15 = lane & 15, quad = lane >> 4;
  const int srow = tid >> 3, skc = tid & 7;
  const bfu* ga = PSUM ? A : A + (long)(row0 + srow) * lda + skc * 8;
  const bfu* gb = Bt + (long)(col0 + srow) * ldb + skc * 8;
  f32x4 acc[4][4];
#pragma unroll
  for (int i = 0; i < 4; ++i)
#pragma unroll
    for (int j = 0; j < 4; ++j) acc[i][j] = f32x4{0.f, 0.f, 0.f, 0.f};
  uint4 ra[4], rb[4];
  float ssq[4] = {0.f, 0.f, 0.f, 0.f};
  const int nk = K >> 6;
#pragma unroll
  for (int i = 0; i < 4; ++i) { if (PSUM) ra[i] = psum_load((const float*)A, (int)lda, row0 + srow + 32 * i, skc * 8); else ra[i] = *(const uint4*)(ga + (long)(32 * i) * lda); rb[i] = *(const uint4*)(gb + (long)(32 * i) * ldb); }
#pragma unroll
  for (int i = 0; i < 4; ++i) {
    *(uint4*)(sA + (srow + 32 * i) * G_LD + skc * 8) = make_uint4(ra[i].x, ra[i].y, ra[i].z, ra[i].w);
    *(uint4*)(sB + (srow + 32 * i) * G_LD + skc * 8) = make_uint4(rb[i].x, rb[i].y, rb[i].z, rb[i].w);
    if (SSQ) { float a0 = blo(ra[i].x), a1 = bhi(ra[i].x), a2 = blo(ra[i].y), a3 = bhi(ra[i].y), a4 = blo(ra[i].z), a5 = bhi(ra[i].z), a6 = blo(ra[i].w), a7 = bhi(ra[i].w);
      ssq[i] += a0 * a0 + a1 * a1 + a2 * a2 + a3 * a3 + a4 * a4 + a5 * a5 + a6 * a6 + a7 * a7; }
  }
  __syncthreads();
  for (int kt = 0; kt < nk; ++kt) {
    const int buf = kt & 1;
    const bool more = (kt + 1 < nk);
    if (more) {
#pragma unroll
      for (int i = 0; i < 4; ++i) { if (PSUM) ra[i] = psum_load((const float*)A, (int)lda, row0 + srow + 32 * i, skc * 8 + (kt + 1) * 64); else ra[i] = *(const uint4*)(ga + (long)(32 * i) * lda + (kt + 1) * 64); rb[i] = *(const uint4*)(gb + (long)(32 * i) * ldb + (kt + 1) * 64); }
    }
    const bfu* pa = sA + buf * 128 * G_LD + (wm * 64 + l15) * G_LD + quad * 8;
    const bfu* pb = sB + buf * 128 * G_LD + (wn * 64 + l15) * G_LD + quad * 8;
#pragma unroll
    for (int ks = 0; ks < 2; ++ks) {
      bf16x8 a[4], b[4];
#pragma unroll
      for (int i = 0; i < 4; ++i) { a[i] = *(const bf16x8*)(pa + i * 16 * G_LD + ks * 32); b[i] = *(const bf16x8*)(pb + i * 16 * G_LD + ks * 32); }
#pragma unroll
      for (int i = 0; i < 4; ++i)
#pragma unroll
        for (int j = 0; j < 4; ++j) acc[i][j] = __builtin_amdgcn_mfma_f32_16x16x32_bf16(a[i], b[j], acc[i][j], 0, 0, 0);
    }
    if (more) {
      const int nb = buf ^ 1;
#pragma unroll
      for (int i = 0; i < 4; ++i) {
        *(uint4*)(sA + nb * 128 * G_LD + (srow + 32 * i) * G_LD + skc * 8) = make_uint4(ra[i].x, ra[i].y, ra[i].z, ra[i].w);
        *(uint4*)(sB + nb * 128 * G_LD + (srow + 32 * i) * G_LD + skc * 8) = make_uint4(rb[i].x, rb[i].y, rb[i].z, rb[i].w);
        if (SSQ) { float a0 = blo(ra[i].x), a1 = bhi(ra[i].x), a2 = blo(ra[i].y), a3 = bhi(ra[i].y), a4 = blo(ra[i].z), a5 = bhi(ra[i].z), a6 = blo(ra[i].w), a7 = bhi(ra[i].w);
          ssq[i] += a0 * a0 + a1 * a1 + a2 * a2 + a3 * a3 + a4 * a4 + a5 * a5 + a6 * a6 + a7 * a7; }
      }
    }
    __syncthreads();
  }
  if (SSQ) {
#pragma unroll
    for (int i = 0; i < 4; ++i) {
      float v = ssq[i];
      v += __shfl_xor(v, 1); v += __shfl_xor(v, 2); v += __shfl_xor(v, 4);
      if (skc == 0) rs[srow + 32 * i] = rsqrtf(v / (float)K + EPS);
    }
    __syncthreads();
#pragma unroll
    for (int mi = 0; mi < 4; ++mi)
#pragma unroll
      for (int j = 0; j < 4; ++j) {
        float r = rs[wm * 64 + mi * 16 + quad * 4 + j];
#pragma unroll
        for (int ni = 0; ni < 4; ++ni) acc[mi][ni][j] *= r;
      }
  }
#pragma unroll
  for (int mi = 0; mi < 4; ++mi) epi(row0 + wm * 64 + mi * 16 + quad * 4, col0 + wn * 64, l15, acc[mi]);
  if (SSQ) __syncthreads();
}

DI void st_rows(bfu* dst, long ld, int r4, int col, int l15, const f32x4 (&a)[4], float sc) {
#pragma unroll
  for (int j = 0; j < 4; ++j)
#pragma unroll
    for (int ni = 0; ni < 4; ++ni) dst[(long)(r4 + j) * ld + col + ni * 16 + l15] = f2b(a[ni][j] * sc);
}
DI void st_T(bfu* dstT, long ldt, int dcol0, int t4, int l15, const f32x4 (&a)[4]) {
#pragma unroll
  for (int ni = 0; ni < 4; ++ni) {
    uint2 v; v.x = pk2(a[ni][0], a[ni][1]); v.y = pk2(a[ni][2], a[ni][3]);
    *(uint2*)(dstT + (long)(dcol0 + ni * 16 + l15) * ldt + t4) = v;
  }
}
DI void rope4(f32x4 (&o)[4], const f32x4 (&a)[4], const float* cs, const float* sn, int r4, int l15) {
#pragma unroll
  for (int j = 0; j < 4; ++j) {
    int pos = (r4 + j) & (SEQ - 1);
#pragma unroll
    for (int n = 0; n < 2; ++n) {
      float c = cs[pos * 32 + n * 16 + l15], s = sn[pos * 32 + n * 16 + l15];
      float x1 = a[n][j], x2 = a[n + 2][j];
      o[n][j] = x1 * c - x2 * s; o[n + 2][j] = x1 * s + x2 * c;
    }
  }
}

struct EpiInProj {
  char* ws;
  DI void operator()(int r4, int c0, int l15, const f32x4 (&a)[4]) const {
    const int b = r4 >> 12, t4 = r4 & (SEQ - 1);
    if (c0 < 512) st_rows((bfu*)(ws + O_CQ), 512, r4, c0, l15, a, 1.f);
    else if (c0 < 1024) st_rows((bfu*)(ws + O_CKV), 512, r4, c0 - 512, l15, a, 1.f);
    else if (c0 < 1088) { f32x4 o[4]; rope4(o, a, (const float*)(ws + O_COS), (const float*)(ws + O_SIN), r4, l15); st_rows((bfu*)(ws + O_KPE), 64, r4, 0, l15, o, 1.f); }
    else if (c0 < 2112 || (c0 >= 3968 && c0 < 4480) || c0 >= 4992) {
      int zc = (c0 < 2112) ? c0 - 1088 : (c0 < 4480 ? c0 - 3968 + 1024 : c0 - 4992 + 1536);
      bfu* dst = (bfu*)(ws + O_ZS);
#pragma unroll
      for (int j = 0; j < 4; ++j)
#pragma unroll
        for (int ni = 0; ni < 4; ++ni) dst[(long)(r4 + j) * 2048 + zc + ni * 16 + l15] = f2b(siluf(a[ni][j]));
    }
    else if (c0 < 2880) st_rows((bfu*)(ws + O_QNSA), 768, r4, c0 - 2112, l15, a, 0.07216878364870322f * LOG2E);
    else if (c0 < 3072) st_rows((bfu*)(ws + O_KC), 192, r4, c0 - 2880, l15, a, 1.f);
    else if (c0 < 3200) st_rows((bfu*)(ws + O_VC), 128, r4, c0 - 3072, l15, a, 1.f);
    else if (c0 < 3392) st_rows((bfu*)(ws + O_KS), 192, r4, c0 - 3200, l15, a, 1.f);
    else if (c0 < 3520) st_T((bfu*)(ws + O_VST) + (long)b * 128 * SEQ, SEQ, c0 - 3392, t4, l15, a);
    else if (c0 < 3712) st_rows((bfu*)(ws + O_KW), 192, r4, c0 - 3520, l15, a, 1.f);
    else if (c0 < 3840) st_T((bfu*)(ws + O_VWT) + (long)b * 128 * SEQ, SEQ, c0 - 3712, t4, l15, a);
    else if (c0 < 3904) {
      if (l15 < 12) {
        float* g = (float*)(ws + O_GATES);
#pragma unroll
        for (int j = 0; j < 4; ++j) g[(long)(r4 + j) * 16 + l15] = 1.f / (1.f + __expf(-a[0][j]));
      }
    }
    else if (c0 < 3968) {}
    else st_rows((bfu*)(ws + O_QMEM), 512, r4, c0 - 4480, l15, a, 0.08838834764831845f * LOG2E);
  }
};
struct EpiMemKV {
  char* ws;
  DI void operator()(int r4, int c0, int l15, const f32x4 (&a)[4]) const {
    if (c0 < 512) st_rows((bfu*)(ws + O_MEMK), 512, r4, c0, l15, a, 1.f);
    else { int b = r4 >> 8, m4 = r4 & 255; st_T((bfu*)(ws + O_MEMVT) + (long)b * 512 * 256, 256, c0 - 512, m4, l15, a); }
  }
};
struct EpiUQ {
  char* ws;
  DI void operator()(int r4, int c0, int l15, const f32x4 (&a)[4]) const {
    const float sc = 0.07216878364870322f * LOG2E;
    if ((c0 % 192) == 128) { f32x4 o[4]; rope4(o, a, (const float*)(ws + O_COS), (const float*)(ws + O_SIN), r4, l15); st_rows((bfu*)(ws + O_QMLA), 1536, r4, c0, l15, o, sc); }
    else st_rows((bfu*)(ws + O_QMLA), 1536, r4, c0, l15, a, sc);
  }
};
struct EpiUKV {
  char* ws;
  DI void operator()(int r4, int c0, int l15, const f32x4 (&a)[4]) const {
    const int head = c0 >> 8, within = c0 & 255;
    if (within < 128) st_rows((bfu*)(ws + O_KNOPE), 1024, r4, head * 128 + within, l15, a, 1.f);
    else { int b = r4 >> 12, t4 = r4 & (SEQ - 1); st_T((bfu*)(ws + O_VMLAT) + (long)(b * 8 + head) * 128 * SEQ, SEQ, within - 128, t4, l15, a); }
  }
};
struct EpiC1 {
  const float* biasp; float* dst; int N; int chunk;
  DI void operator()(int r4, int c0, int l15, const f32x4 (&a)[4]) const {
#pragma unroll
    for (int ni = 0; ni < 4; ++ni) {
      int n = c0 + ni * 16 + l15;
      if (n < N) {
        float bsum = 0.f;
#pragma unroll
        for (int ch = 0; ch < 4; ++ch) bsum += biasp[(chunk * 4 + ch) * 256 + n];
#pragma unroll
        for (int j = 0; j < 4; ++j) dst[((long)chunk * 1024 + r4 + j) * N + n] = a[ni][j] + bsum;
      }
    }
  }
};
struct EpiC2K {
  char* ws;
  DI void operator()(int r4, int c0, int l15, const f32x4 (&a)[4]) const {
    bfu* dst = (bfu*)(ws + O_KCMP);
#pragma unroll
    for (int ni = 0; ni < 4; ++ni) { int n = c0 + ni * 16 + l15;
      if (n < 192) {
#pragma unroll
        for (int j = 0; j < 4; ++j) dst[(long)(r4 + j) * 192 + n] = f2b(a[ni][j]); } }
  }
};
struct EpiC2V {
  char* ws;
  DI void operator()(int r4, int c0, int l15, const f32x4 (&a)[4]) const {
    int b = r4 >> 8, n4 = r4 & 255;
    st_T((bfu*)(ws + O_VCMPT) + (long)b * 128 * 256, 256, c0, n4, l15, a);
  }
};
struct EpiOut {
  const float* x; float* out; float* ssqp;
  DI void operator()(int r4, int c0, int l15, const f32x4 (&a)[4]) const {
#pragma unroll
    for (int j = 0; j < 4; ++j) {
      float ss = 0.f;
#pragma unroll
      for (int ni = 0; ni < 4; ++ni) {
        long idx = (long)(r4 + j) * DM + c0 + ni * 16 + l15;
        float y = a[ni][j] + x[idx];
        out[idx] = y; ss += y * y;
      }
      ss += __shfl_xor(ss, 1); ss += __shfl_xor(ss, 2); ss += __shfl_xor(ss, 4); ss += __shfl_xor(ss, 8);
      if (l15 == 0) ssqp[(long)(r4 + j) * 32 + (c0 >> 6)] = ss;
    }
  }
};

DI void rms_row(const float* __restrict__ src, const float* __restrict__ g, bfu* __restrict__ dst, int lane) {
  const float4* s4 = (const float4*)src;
  float4 v[8]; float ss = 0.f;
#pragma unroll
  for (int i = 0; i < 8; ++i) { v[i] = s4[lane + 64 * i]; ss += v[i].x * v[i].x + v[i].y * v[i].y + v[i].z * v[i].z + v[i].w * v[i].w; }
  ss = wave_sum(ss);
  const float r = rsqrtf(ss * (1.f / 2048.f) + EPS);
#pragma unroll
  for (int i = 0; i < 8; ++i) {
    float4 gg = ((const float4*)g)[lane + 64 * i];
    uint2 o; o.x = pk2(v[i].x * r * gg.x, v[i].y * r * gg.y); o.y = pk2(v[i].z * r * gg.z, v[i].w * r * gg.w);
    *(uint2*)(dst + (lane + 64 * i) * 4) = o;
  }
}
DI void tr_tile(const float* __restrict__ src, const float* __restrict__ g, bfu* __restrict__ dst, int K, int Nsrc,
                int nvalid1, int nzero_end, int nshift, int kt, int nt, float* tile) {
  const int tid = otid();
  const int k0 = kt * 64, n0 = nt * 64;
  const int nn = (tid & 15) * 4, np = n0 + nn;
  int sn = (np < nvalid1) ? np : (np < nzero_end ? -1 : np - nshift);
  if (sn >= Nsrc) sn = -1;
#pragma unroll
  for (int i = 0; i < 4; ++i) {
    int kk = (tid >> 4) + 16 * i;
    float4 v = make_float4(0.f, 0.f, 0.f, 0.f);
    if (sn >= 0) {
      v = *(const float4*)(src + (long)(k0 + kk) * Nsrc + sn);
      if (g) { float gg = g[k0 + kk]; v.x *= gg; v.y *= gg; v.z *= gg; v.w *= gg; }
    }
    tile[kk * 65 + nn + 0] = v.x; tile[kk * 65 + nn + 1] = v.y; tile[kk * 65 + nn + 2] = v.z; tile[kk * 65 + nn + 3] = v.w;
  }
  __syncthreads();
  const int nn2 = tid >> 2, kseg = (tid & 3) * 16;
  unsigned w[8];
#pragma unroll
  for (int e = 0; e < 8; ++e) w[e] = pk2(tile[(kseg + 2 * e) * 65 + nn2], tile[(kseg + 2 * e + 1) * 65 + nn2]);
  bfu* d = dst + (long)(n0 + nn2) * K + k0 + kseg;
  *(uint4*)d = make_uint4(w[0], w[1], w[2], w[3]);
  *(uint4*)(d + 8) = make_uint4(w[4], w[5], w[6], w[7]);
  __syncthreads();
}

DI void phase0(const Params& P, char* smem) {
  char* ws = P.ws;
  const int tid = otid(), lane = tid & 63, wave = tid >> 6;
  float* tile = (float*)smem;
  constexpr int N_XN = 4096, N_MEMN = 256;
  constexpr int T_IN = 32 * 86, T_UQ = 8 * 24, T_UKV = 8 * 32, T_C1K = 96 * 4, T_C1V = 64 * 2, T_C2K = 3 * 4, T_C2V = 2 * 2, T_MKV = 32 * 16, T_OUT = 32 * 32;
  constexpr int N_CS = 512, N_BIAS = 64;
  constexpr int S1 = N_XN, S2 = S1 + N_MEMN, S3 = S2 + T_IN, S4 = S3 + T_UQ, S5 = S4 + T_UKV, S6 = S5 + T_C1K, S7 = S6 + T_C1V,
                S8 = S7 + T_C2K, S9 = S8 + T_C2V, S10 = S9 + T_MKV, S11 = S10 + T_OUT, S12 = S11 + N_CS, S13 = S12 + N_BIAS;
  for (int it = blockIdx.x; it < S13; it += gridDim.x) {
    if (it < S1) { int row = it * 4 + wave; rms_row(P.x + (long)row * DM, P.norm_g, (bfu*)(ws + O_XN) + (long)row * DM, lane); }
    else if (it < S2) { int row = (it - S1) * 4 + wave; rms_row(P.mem + (long)row * DM, P.mem_norm_g, (bfu*)(ws + O_MEMN) + (long)row * DM, lane); }
    else if (it < S3) { int i = it - S2; tr_tile(P.w_in, nullptr, (bfu*)(ws + O_WT_IN), 2048, DIN, 3852, 3968, 116, i / 86, i % 86, tile); }
    else if (it < S4) { int i = it - S3; tr_tile(P.w_uq, P.q_norm_g, (bfu*)(ws + O_WT_UQ), 512, 1536, 1536, 1 << 30, 0, i / 24, i % 24, tile); }
    else if (it < S5) { int i = it - S4; tr_tile(P.w_ukv, P.kv_norm_g, (bfu*)(ws + O_WT_UKV), 512, 2048, 2048, 1 << 30, 0, i / 32, i % 32, tile); }
    else if (it < S6) { int i = it - S5; tr_tile(P.cmp_w1k, nullptr, (bfu*)(ws + O_WT_C1K), 6144, 192, 192, 1 << 30, 0, i / 4, i % 4, tile); }
    else if (it < S7) { int i = it - S6; tr_tile(P.cmp_w1v, nullptr, (bfu*)(ws + O_WT_C1V), 4096, 128, 128, 1 << 30, 0, i / 2, i % 2, tile); }
    else if (it < S8) { int i = it - S7; tr_tile(P.cmp_w2k, nullptr, (bfu*)(ws + O_WT_C2K), 192, 192, 192, 1 << 30, 0, i / 4, i % 4, tile); }
    else if (it < S9) { int i = it - S8; tr_tile(P.cmp_w2v, nullptr, (bfu*)(ws + O_WT_C2V), 128, 128, 128, 1 << 30, 0, i / 2, i % 2, tile); }
    else if (it < S10) { int i = it - S9; tr_tile(P.w_mem_kv, nullptr, (bfu*)(ws + O_WT_MKV), 2048, 1024, 1024, 1 << 30, 0, i / 16, i % 16, tile); }
    else if (it < S11) { int i = it - S10; tr_tile(P.w_out, nullptr, (bfu*)(ws + O_WT_OUT), 2048, 2048, 2048, 1 << 30, 0, i / 32, i % 32, tile); }
    else if (it < S12) {
      int idx = (it - S11) * 256 + tid; int pos = idx >> 5, i = idx & 31;
      float ang = (float)pos * INVF[i];
      float rev = ang * 0.15915494309189535f;
      rev = rev - floorf(rev);
      ((float*)(ws + O_COS))[idx] = __builtin_amdgcn_cosf(rev);
      ((float*)(ws + O_SIN))[idx] = __builtin_amdgcn_sinf(rev);
    }
    else {
      int i = it - S12;
      if (i < 32) { if (tid < 192) { float acc = 0.f; for (int k = i * 192; k < (i + 1) * 192; ++k) acc += P.cmp_pe_k[k] * P.cmp_w1k[(long)k * 192 + tid]; ((float*)(ws + O_BIASK))[i * 256 + tid] = acc; } }
      else { int c = i - 32; if (tid < 128) { float acc = 0.f; for (int k = c * 128; k < (c + 1) * 128; ++k) acc += P.cmp_pe_v[k] * P.cmp_w1v[(long)k * 128 + tid]; ((float*)(ws + O_BIASV))[c * 256 + tid] = acc; } }
    }
  }
}

enum { M_MLA = 0, M_MEM = 1, M_CMP1 = 2, M_CMP2 = 3, M_SLC = 4, M_WIN = 5 };
struct KVSrc { const bfu *k1, *k2, *vt; int ldk1, ldk2, ldvt; };
template <int DQK> struct KVRegs { uint4 k[DQK / 32]; uint4 v[4]; };

template <int DQK>
DI void kv_gload(KVRegs<DQK>& r, const KVSrc& s, int key0, int tid) {
  const int key = tid >> 2, kq = tid & 3;
  const unsigned o1 = (unsigned)(key0 + key) * (unsigned)s.ldk1 + kq * 8;
  const unsigned o2 = (unsigned)(key0 + key) * (unsigned)s.ldk2 + kq * 8;
#pragma unroll
  for (int i = 0; i < DQK / 32; ++i) {
    if (i < 4) r.k[i] = *(const uint4*)(s.k1 + o1 + i * 32);
    else r.k[i] = *(const uint4*)(s.k2 + o2 + (i - 4) * 32);
  }
  const unsigned ov = (unsigned)(tid >> 3) * (unsigned)s.ldvt + key0 + (tid & 7) * 8;
#pragma unroll
  for (int i = 0; i < 4; ++i) r.v[i] = *(const uint4*)(s.vt + (long)(i * 32) * s.ldvt + ov);
}
template <int DQK>
DI void kv_sstore(const KVRegs<DQK>& r, bfu* sK, bfu* sVt, int tid) {
  constexpr int LDK = DQK + 8;
  const int key = tid >> 2, kq = tid & 3;
#pragma unroll
  for (int i = 0; i < DQK / 32; ++i)
    *(uint4*)(sK + key * LDK + (kq + 4 * i) * 8) = make_uint4(r.k[i].x, r.k[i].y, r.k[i].z, r.k[i].w);
  const int kc = tid & 7;
  const int pos = 16 * (kc >> 1) + 4 * (kc & 1);
#pragma unroll
  for (int i = 0; i < 4; ++i) {
    const int d = (tid >> 3) + 32 * i;
    *(uint2*)(sVt + d * 72 + pos) = make_uint2(r.v[i].x, r.v[i].y);
    *(uint2*)(sVt + d * 72 + pos + 8) = make_uint2(r.v[i].z, r.v[i].w);
  }
}

struct LaneCtx {
  int t;
  float slope2;
  unsigned long long selmask;
  float invl;
  float carry;
  float* slab;
  int twave_min, twave_max;
};

template <int DQK, int MODE>
DI void attn_tile(const bf16x8 (&q)[DQK / 16], f32x16 (&o)[4], float& m, float& l, LaneCtx& cx, int jt, const bfu* sK, const bfu* sVt, int lane) {
  constexpr int LDK = DQK + 8;
  constexpr bool ISCMP = (MODE == M_CMP1 || MODE == M_CMP2);
  const int h = lane >> 5;
  const int key0 = jt * 64;
  bool sel = true;
  if (MODE == M_SLC) sel = (cx.selmask >> jt) & 1ull;
#pragma unroll
  for (int sub = 0; sub < 2; ++sub) {
    const int kb0 = key0 + 32 * sub;
    if (MODE == M_MLA) { if (kb0 > cx.twave_max) continue; }
    f32x16 s0;
#pragma unroll
    for (int i = 0; i < 16; ++i) s0[i] = 0.f;
    {
      const bfu* p = sK + (sub * 32 + (lane & 31)) * LDK + 8 * h;
#pragma unroll
      for (int ks = 0; ks < DQK / 16; ++ks) {
        bf16x8 a0 = *(const bf16x8*)(p + 16 * ks);
        s0 = __builtin_amdgcn_mfma_f32_32x32x16_bf16(a0, q[ks], s0, 0, 0, 0);
      }
    }
    if (MODE != M_MEM) {
      bool domask = true;
      if (MODE == M_MLA) domask = (kb0 + 31 > cx.twave_min);
      if (domask) {
        constexpr float KST = ISCMP ? 16.f : 1.f;
        const float vmax = ISCMP ? -15.5f : 0.f;
        float fd;
        if (ISCMP) fd = (float)(16 * (kb0 + 4 * h) - cx.t) + 15.5f;
        else fd = (float)(kb0 + 4 * h - cx.t);
#pragma unroll
        for (int i = 0; i < 16; ++i) {
          const float c0 = KST * (float)((i & 3) + 8 * (i >> 2));
          float d0 = fd + c0;
          bool v0 = (d0 <= vmax) && sel;
          if (MODE == M_WIN) v0 = v0 && (d0 > -512.f);
          float x0 = s0[i];
          if (MODE != M_MLA) x0 = fmaf(cx.slope2, d0, x0);
          s0[i] = v0 ? x0 : -INFINITY;
        }
      }
    }
    if (MODE == M_CMP2) {
      const float mm = m, il = cx.invl;
#pragma unroll
      for (int i = 0; i < 16; ++i) s0[i] = __builtin_amdgcn_exp2f(s0[i] - mm) * il;
      float sum4[4], recv[4];
#pragma unroll
      for (int a = 0; a < 4; ++a) sum4[a] = s0[4 * a] + s0[4 * a + 1] + s0[4 * a + 2] + s0[4 * a + 3];
      recv[0] = __shfl_xor(s0[3], 32); recv[1] = __shfl_xor(s0[7], 32); recv[2] = __shfl_xor(s0[11], 32); recv[3] = __shfl_xor(s0[15], 32);
      const float p0 = h ? recv[0] : cx.carry;
      const float p1 = h ? recv[1] : recv[0];
      const float p2 = h ? recv[2] : recv[1];
      const float p3 = h ? recv[3] : recv[2];
      cx.carry = recv[3];
      const int G = jt * 16 + sub * 8 + h;
      cx.slab[G] = sum4[0] + p0; cx.slab[G + 2] = sum4[1] + p1; cx.slab[G + 4] = sum4[2] + p2; cx.slab[G + 6] = sum4[3] + p3;
    } else {
      float mx = s0[0];
#pragma unroll
      for (int i = 1; i < 16; ++i) mx = fmaxf(mx, s0[i]);
      mx = xhalf_max(mx);
      const float mn = fmaxf(m, mx);
      const float alpha = __builtin_amdgcn_exp2f(m - mn);
      m = mn;
      float ps = 0.f;
#pragma unroll
      for (int i = 0; i < 16; ++i) { s0[i] = __builtin_amdgcn_exp2f(s0[i] - mn); ps += s0[i]; }
      l = l * alpha + ps;
      if (MODE != M_CMP1) {
        if (!__all(alpha == 1.f)) {
#pragma unroll
          for (int dt = 0; dt < 4; ++dt)
#pragma unroll
            for (int i = 0; i < 16; ++i) o[dt][i] *= alpha;
        }
      }
    }
    if (MODE != M_CMP1) {
      const bfu* p = sVt + (lane & 31) * 72 + 8 * h + 32 * sub;
#pragma unroll
      for (int s2 = 0; s2 < 2; ++s2) {
        const int bs = 8 * s2;
        u32x4 w;
        w[0] = pk2(s0[bs], s0[bs + 1]); w[1] = pk2(s0[bs + 2], s0[bs + 3]); w[2] = pk2(s0[bs + 4], s0[bs + 5]); w[3] = pk2(s0[bs + 6], s0[bs + 7]);
        bf16x8 pb = __builtin_bit_cast(bf16x8, w);
#pragma unroll
        for (int dt = 0; dt < 4; ++dt) {
          bf16x8 a = *(const bf16x8*)(p + dt * 32 * 72 + 16 * s2);
          o[dt] = __builtin_amdgcn_mfma_f32_32x32x16_bf16(a, pb, o[dt], 0, 0, 0);
        }
      }
    }
  }
}

template <int DQK, int MODE>
DI void flash(const bf16x8 (&q)[DQK / 16], f32x16 (&o)[4], float& m, float& l, LaneCtx& cx, const KVSrc& src,
              unsigned long long tilemask, bfu* sK, bfu* sVt) {
  const int tid = otid(), lane = tid & 63;
  unsigned lo = __builtin_amdgcn_readfirstlane((unsigned)tilemask), hi = __builtin_amdgcn_readfirstlane((unsigned)(tilemask >> 32));
  unsigned long long rem = ((unsigned long long)hi << 32) | lo;
  if (rem == 0ull) return;
  int j = __builtin_ctzll(rem); rem &= rem - 1;
  KVRegs<DQK> r;
  kv_gload<DQK>(r, src, j * 64, tid);
  kv_sstore<DQK>(r, sK, sVt, tid);
  __syncthreads();
  while (true) {
    int jn = -1;
    if (rem != 0ull) { jn = __builtin_ctzll(rem); rem &= rem - 1; kv_gload<DQK>(r, src, jn * 64, tid); }
    attn_tile<DQK, MODE>(q, o, m, l, cx, j, sK, sVt, lane);
    __syncthreads();
    if (jn < 0) break;
    kv_sstore<DQK>(r, sK, sVt, tid);
    __syncthreads();
    j = jn;
  }
}

DI unsigned long long bits_upto(int n) { return n >= 64 ? ~0ull : ((1ull << n) - 1ull); }

template <int DQK>
DI void load_q(bf16x8 (&q)[DQK / 16], const bfu* Q, long ldq, int lane) {
  const bfu* p = Q + (long)(lane & 31) * ldq + 8 * (lane >> 5);
#pragma unroll
  for (int ks = 0; ks < DQK / 16; ++ks) q[ks] = *(const bf16x8*)(p + 16 * ks);
}

DI void store_gated(const f32x16 (&o)[4], float sc, const bfu* zs, bfu* dst, int h) {
#pragma unroll
  for (int dt = 0; dt < 4; ++dt)
#pragma unroll
    for (int g = 0; g < 4; ++g) {
      int d = 32 * dt + 8 * g + 4 * h;
      uint2 z = *(const uint2*)(zs + d);
      uint2 w;
      w.x = pk2(o[dt][4 * g] * sc * blo(z.x), o[dt][4 * g + 1] * sc * bhi(z.x));
      w.y = pk2(o[dt][4 * g + 2] * sc * blo(z.y), o[dt][4 * g + 3] * sc * bhi(z.y));
      *(uint2*)(dst + d) = w;
    }
}

DI void mla_item(const Params& P, int b, int head, int qt, char* smem) {
  char* ws = P.ws;
  bfu* sK = (bfu*)smem; bfu* sVt = (bfu*)(smem + 25600);
  const int tid = otid(), lane = tid & 63, wave = tid >> 6, h = lane >> 5, ql = lane & 31;
  const int tq0 = qt * 128 + wave * 32;
  const long tok0 = (long)b * SEQ + tq0;
  bf16x8 q[12];
  load_q<192>(q, (const bfu*)(ws + O_QMLA) + tok0 * 1536 + head * 192, 1536, lane);
  KVSrc src;
  src.k1 = (const bfu*)(ws + O_KNOPE) + (long)b * SEQ * 1024 + head * 128; src.ldk1 = 1024;
  src.k2 = (const bfu*)(ws + O_KPE) + (long)b * SEQ * 64; src.ldk2 = 64;
  src.vt = (const bfu*)(ws + O_VMLAT) + (long)(b * 8 + head) * 128 * SEQ; src.ldvt = SEQ;
  LaneCtx cx; cx.t = tq0 + ql; cx.slope2 = 0.f; cx.selmask = 0; cx.invl = 0.f; cx.carry = 0.f; cx.slab = nullptr; cx.twave_min = tq0; cx.twave_max = tq0 + 31;
  f32x16 o[4];
#pragma unroll
  for (int dt = 0; dt < 4; ++dt)
#pragma unroll
    for (int i = 0; i < 16; ++i) o[dt][i] = 0.f;
  float m = -1e30f, l = 0.f;
  flash<192, M_MLA>(q, o, m, l, cx, src, bits_upto(2 * (qt + 1)), sK, sVt);
  const float lt = xhalf_sum(l);
  const float sc = 1.f / (lt + 1e-20f);
  const long tok = tok0 + ql;
  store_gated(o, sc, (const bfu*)(ws + O_ZS) + tok * 2048 + head * 128, (bfu*)(ws + O_OCAT) + tok * 2048 + head * 128, h);
}

DI void mem_item(const Params& P, int b, int head, int qt, char* smem) {
  char* ws = P.ws;
  bfu* sK = (bfu*)smem; bfu* sVt = (bfu*)(smem + 25600);
  const int tid = otid(), lane = tid & 63, wave = tid >> 6, h = lane >> 5, ql = lane & 31;
  const int tq0 = qt * 128 + wave * 32;
  const long tok0 = (long)b * SEQ + tq0;
  bf16x8 q[8];
  load_q<128>(q, (const bfu*)(ws + O_QMEM) + tok0 * 512 + head * 128, 512, lane);
  KVSrc src;
  src.k1 = (const bfu*)(ws + O_MEMK) + (long)b * 256 * 512 + head * 128; src.ldk1 = 512;
  src.k2 = src.k1; src.ldk2 = 512;
  src.vt = (const bfu*)(ws + O_MEMVT) + (long)(b * 4 + head) * 128 * 256; src.ldvt = 256;
  LaneCtx cx; cx.t = 0; cx.slope2 = 0.f; cx.selmask = 0; cx.invl = 0.f; cx.carry = 0.f; cx.slab = nullptr; cx.twave_min = 0; cx.twave_max = 0;
  f32x16 o[4];
#pragma unroll
  for (int dt = 0; dt < 4; ++dt)
#pragma unroll
    for (int i = 0; i < 16; ++i) o[dt][i] = 0.f;
  float m = -1e30f, l = 0.f;
  flash<128, M_MEM>(q, o, m, l, cx, src, 0xFull, sK, sVt);
  const float lt = xhalf_sum(l);
  const float sc = 1.f / lt;
  const long tok = tok0 + ql;
  store_gated(o, sc, (const bfu*)(ws + O_ZS) + tok * 2048 + 1536 + head * 128, (bfu*)(ws + O_OCAT) + tok * 2048 + 1536 + head * 128, h);
}

DI void onsa_acc(const f32x16 (&o)[4], float sc, float* dst, int h, bool add) {
#pragma unroll
  for (int dt = 0; dt < 4; ++dt)
#pragma unroll
    for (int g = 0; g < 4; ++g) {
      int d = 32 * dt + 8 * g + 4 * h;
      float4 v = make_float4(o[dt][4 * g] * sc, o[dt][4 * g + 1] * sc, o[dt][4 * g + 2] * sc, o[dt][4 * g + 3] * sc);
      if (add) { float4 p = *(const float4*)(dst + d); v.x += p.x; v.y += p.y; v.z += p.z; v.w += p.w; }
      *(float4*)(dst + d) = v;
    }
}

DI void nsa_item(const Params& P, int b, int qt, char* smem) {
  char* ws = P.ws;
  bfu* sK = (bfu*)smem; bfu* sVt = (bfu*)(smem + 25600);
  float* slab = (float*)(smem + 45056);
  unsigned long long* selm = (unsigned long long*)(smem + 77824);
  const int tid = otid(), lane = tid & 63, wave = tid >> 6, h = lane >> 5, ql = lane & 31;
  const int head = wave;
  const int t0 = qt * 32;
  const long tok0 = (long)b * SEQ + t0;
  const long tok = tok0 + ql;
  bf16x8 q[12];
  load_q<192>(q, (const bfu*)(ws + O_QNSA) + tok0 * 768 + head * 192, 768, lane);
  const float* gp = (const float*)(ws + O_GATES) + tok * 16 + head * 3;
  const float g0 = gp[0], g1 = gp[1], g2 = gp[2];
  float* onsa = (float*)(ws + O_ONSA) + tok * 512 + head * 128;
  LaneCtx cx; cx.t = t0 + ql; cx.slope2 = exp2f(-2.f * (float)(head + 1)) * LOG2E; cx.selmask = 0; cx.invl = 0.f; cx.carry = 0.f;
  cx.slab = slab + (wave * 32 + ql) * 64; cx.twave_min = t0; cx.twave_max = t0 + 31;
#pragma unroll
  for (int i = 0; i < 32; ++i) slab[tid + 256 * i] = 0.f;
  __syncthreads();
  f32x16 o[4];
  float m, l;
  {
    KVSrc src;
    src.k1 = (const bfu*)(ws + O_KCMP) + (long)b * 256 * 192; src.ldk1 = 192;
    src.k2 = src.k1 + 128; src.ldk2 = 192;
    src.vt = (const bfu*)(ws + O_VCMPT) + (long)b * 128 * 256; src.ldvt = 256;
    const int ntc = ((t0 >> 4) >> 6) + 1;
    m = -1e30f; l = 0.f;
    flash<192, M_CMP1>(q, o, m, l, cx, src, bits_upto(ntc), sK, sVt);
    const float lt = xhalf_sum(l);
    cx.invl = 1.f / (lt + 1e-20f);
#pragma unroll
    for (int dt = 0; dt < 4; ++dt)
#pragma unroll
      for (int i = 0; i < 16; ++i) o[dt][i] = 0.f;
    flash<192, M_CMP2>(q, o, m, l, cx, src, bits_upto(ntc), sK, sVt);
    onsa_acc(o, g0, onsa, h, false);
  }
  __syncthreads();
  const int cur = t0 >> 6;
  for (int qi = 0; qi < 8; ++qi) {
    const int qq = wave * 8 + qi;
    float v = slab[(0 * 32 + qq) * 64 + lane] + slab[(1 * 32 + qq) * 64 + lane] + slab[(2 * 32 + qq) * 64 + lane] + slab[(3 * 32 + qq) * 64 + lane];
    const bool forced = (lane == 0) || (lane == cur) || (lane == cur - 1);
    if (forced) v = 1e9f;
    if (lane > cur) v = -1e9f;
    int rank = 0;
#pragma unroll
    for (int j = 0; j < 64; ++j) {
      float vj = __builtin_bit_cast(float, __builtin_amdgcn_readlane(__builtin_bit_cast(int, v), j));
      rank += ((vj > v) || (vj == v && j < lane)) ? 1 : 0;
    }
    unsigned long long msk = __ballot(rank < 16);
    if (lane == 0) selm[qq] = msk;
  }
  __syncthreads();
  {
    const unsigned long long mym = selm[ql];
    unsigned ulo = (unsigned)mym, uhi = (unsigned)(mym >> 32);
#pragma unroll
    for (int off = 16; off >= 1; off >>= 1) { ulo |= __shfl_xor(ulo, off); uhi |= __shfl_xor(uhi, off); }
    unsigned long long uni = (((unsigned long long)uhi) << 32) | ulo;
    uni &= bits_upto(cur + 1);
    cx.selmask = mym;
    KVSrc src;
    src.k1 = (const bfu*)(ws + O_KS) + (long)b * SEQ * 192; src.ldk1 = 192;
    src.k2 = src.k1 + 128; src.ldk2 = 192;
    src.vt = (const bfu*)(ws + O_VST) + (long)b * 128 * SEQ; src.ldvt = SEQ;
    m = -1e30f; l = 0.f;
#pragma unroll
    for (int dt = 0; dt < 4; ++dt)
#pragma unroll
      for (int i = 0; i < 16; ++i) o[dt][i] = 0.f;
    flash<192, M_SLC>(q, o, m, l, cx, src, uni, sK, sVt);
    const float lt = xhalf_sum(l);
    onsa_acc(o, g1 / (lt + 1e-20f), onsa, h, true);
  }
  {
    KVSrc src;
    src.k1 = (const bfu*)(ws + O_KW) + (long)b * SEQ * 192; src.ldk1 = 192;
    src.k2 = src.k1 + 128; src.ldk2 = 192;
    src.vt = (const bfu*)(ws + O_VWT) + (long)b * 128 * SEQ; src.ldvt = SEQ;
    int lo_t = t0 - 511; if (lo_t < 0) lo_t = 0;
    const int j0 = lo_t >> 6, j1 = (t0 + 31) >> 6;
    unsigned long long tm = bits_upto(j1 + 1) & ~bits_upto(j0);
    m = -1e30f; l = 0.f;
#pragma unroll
    for (int dt = 0; dt < 4; ++dt)
#pragma unroll
      for (int i = 0; i < 16; ++i) o[dt][i] = 0.f;
    flash<192, M_WIN>(q, o, m, l, cx, src, tm, sK, sVt);
    const float lt = xhalf_sum(l);
    const float sc = g2 / (lt + 1e-20f);
    const bfu* zs = (const bfu*)(ws + O_ZS) + tok * 2048 + 1024 + head * 128;
    bfu* dst = (bfu*)(ws + O_OCAT) + tok * 2048 + 1024 + head * 128;
#pragma unroll
    for (int dt = 0; dt < 4; ++dt)
#pragma unroll
      for (int g = 0; g < 4; ++g) {
        int d = 32 * dt + 8 * g + 4 * h;
        float4 p = *(const float4*)(onsa + d);
        uint2 z = *(const uint2*)(zs + d);
        uint2 w;
        w.x = pk2((p.x + o[dt][4 * g] * sc) * blo(z.x), (p.y + o[dt][4 * g + 1] * sc) * bhi(z.x));
        w.y = pk2((p.z + o[dt][4 * g + 2] * sc) * blo(z.y), (p.w + o[dt][4 * g + 3] * sc) * bhi(z.y));
        *(uint2*)(dst + d) = w;
      }
  }
}

__global__ void __launch_bounds__(256, 2) mega(Params P) {
  extern __shared__ __attribute__((aligned(16))) char smem[];
  cg::grid_group grid = cg::this_grid();
  char* ws = P.ws;
  const int tid = threadIdx.x;
  unsigned* bar = (unsigned*)(ws + O_CTR);
  unsigned* qbase = (unsigned*)(ws + O_Q);
  int* s_item = (int*)(smem + SMEM_BYTES - 16);
  volatile LAS unsigned* st = (volatile LAS unsigned*)(smem + SMEM_BYTES - 32);
  if (tid == 0) { st[0] = 0u; st[1] = 0u; }
  __syncthreads();
  XcdBarrier xb = xcd_barrier_post(bar, st);
  const int myx = (int)(xb.x & 7u);
  if (P.phase_hi > 1000) grid.sync();
#define RUNPH(n) (P.phase_lo <= (n) && (n) <= P.phase_hi)
#define SYNCPH(n) if (P.phase_lo <= (n) && (n) < P.phase_hi) xcd_barrier(xb);
  {
    if (RUNPH(0)) {
      phase0(P, smem);
    }
    SYNCPH(0)
    if (RUNPH(1)) {
      int cur = myx, tried = 0;
      while (true) {
        const int r = q_pull(qbase + 0 * 128, 696, cur, tried, s_item, tid);
        if (r < 0) break;
        const int x = r >> 20, sq = r & 0xFFFFF;
        if (sq < 688) { int nt = sq >> 4, mt = 16 * x + (sq & 15); EpiInProj e{ws};
          gemm_tile<false, false>((const bfu*)(ws + O_XN), 2048, (const bfu*)(ws + O_WT_IN), 2048, 2048, mt * 128, nt * 128, e, smem); }
        else { int i = x * 8 + (sq - 688); EpiMemKV e{ws};
          gemm_tile<false, false>((const bfu*)(ws + O_MEMN), 2048, (const bfu*)(ws + O_WT_MKV), 2048, 2048, (i >> 3) * 128, (i & 7) * 128, e, smem); }
      }
    }
    SYNCPH(1)
    if (RUNPH(2)) {
      int cur = myx, tried = 0;
      while (true) {
        const int r = q_pull(qbase + 1 * 128, 24 + 256 + 192, cur, tried, s_item, tid);
        if (r < 0) break;
        const int x = r >> 20, sq = r & 0xFFFFF;
        if (sq < 24) {
          int c = x * 24 + sq;
          if (c < 128) { int tile = c >> 3, ch = c & 7; EpiC1 e{(const float*)(ws + O_BIASK), (float*)(ws + O_PARTK), 192, ch};
            gemm_tile<false, false>((const bfu*)(ws + O_KC) + ch * 768, 3072, (const bfu*)(ws + O_WT_C1K) + ch * 768, 6144, 768, (tile >> 1) * 128, (tile & 1) * 128, e, smem); }
          else { c -= 128; int mt = c >> 3, ch = c & 7; EpiC1 e{(const float*)(ws + O_BIASV), (float*)(ws + O_PARTV), 128, ch};
            gemm_tile<false, false>((const bfu*)(ws + O_VC) + ch * 512, 2048, (const bfu*)(ws + O_WT_C1V) + ch * 512, 4096, 512, mt * 128, 0, e, smem); }
        }
        else if (sq < 280) { int i = sq - 24; int nt = i >> 4, mt = 16 * x + (i & 15); EpiUKV e{ws};
          gemm_tile<true, false>((const bfu*)(ws + O_CKV), 512, (const bfu*)(ws + O_WT_UKV), 512, 512, mt * 128, nt * 128, e, smem); }
        else { int i = sq - 280; int nt = i >> 4, mt = 16 * x + (i & 15); EpiUQ e{ws};
          gemm_tile<true, false>((const bfu*)(ws + O_CQ), 512, (const bfu*)(ws + O_WT_UQ), 512, 512, mt * 128, nt * 128, e, smem); }
      }
    }
    SYNCPH(2)
    if (RUNPH(3)) {
      for (int it = blockIdx.x; it < 24; it += gridDim.x) {
        if (it < 16) { EpiC2K e{ws};
          gemm_tile<false, true>((const bfu*)(ws + O_PARTK), 192, (const bfu*)(ws + O_WT_C2K), 192, 192, (it >> 1) * 128, (it & 1) * 128, e, smem); }
        else { int i = it - 16; EpiC2V e{ws};
          gemm_tile<false, true>((const bfu*)(ws + O_PARTV), 128, (const bfu*)(ws + O_WT_C2V), 128, 128, i * 128, 0, e, smem); }
      }
    }
    SYNCPH(3)
    if (RUNPH(4)) {
      unsigned* ctr = qbase + 3 * 128;
      while (true) {
        if (tid == 0) *s_item = (int)atomicAdd(ctr, 1u);
        __syncthreads();
        const int it = *s_item;
        __syncthreads();
        if (it >= 2048) break;
        if (it < 512 || (it >= 1024 && it < 1536)) { int i = (it < 512) ? it : it - 512; int qt = 31 - (i >> 5), bh = i & 31; mla_item(P, bh >> 3, bh & 7, qt, smem); }
        else if (it < 1024) { int i = it - 512; nsa_item(P, i & 3, 127 - (i >> 2), smem); }
        else { int i = it - 1536; mem_item(P, i >> 7, (i >> 5) & 3, i & 31, smem); }
      }
    }
    SYNCPH(4)
    if (RUNPH(5)) {
      EpiOut e{P.x, P.out, (float*)(ws + O_SSQP)};
      int cur = myx, tried = 0;
      while (true) {
        const int r = q_pull(qbase + 2 * 128, 256, cur, tried, s_item, tid);
        if (r < 0) break;
        const int x = r >> 20, sq = r & 0xFFFFF;
        const int nt = sq >> 4, mt = 16 * x + (sq & 15);
        gemm_tile<false, false>((const bfu*)(ws + O_OCAT), 2048, (const bfu*)(ws + O_WT_OUT), 2048, 2048, mt * 128, nt * 128, e, smem);
      }
    }
    SYNCPH(5)
    if (RUNPH(6)) {
      const int lane = tid & 63, wave = tid >> 6;
      const float* sp = (const float*)(ws + O_SSQP);
      for (int it = blockIdx.x; it < NTOK / 4; it += gridDim.x) {
        const int row = it * 4 + wave;
        float s = (lane < 32) ? sp[(long)row * 32 + lane] : 0.f;
        s = wave_sum(s);
        const float r = rsqrtf(s * (1.f / 2048.f) + EPS);
        float4* o4 = (float4*)(P.out + (long)row * DM);
#pragma unroll
        for (int i = 0; i < 8; ++i) {
          float4 v = o4[lane + 64 * i]; float4 g = ((const float4*)P.final_g)[lane + 64 * i];
          v.x *= r * g.x; v.y *= r * g.y; v.z *= r * g.z; v.w *= r * g.w;
          o4[lane + 64 * i] = v;
        }
      }
    }
  }
}

extern "C" void kernel_launch(void* const* d_in, const int* in_sizes, int n_in, void* d_out, int out_size, void* d_ws, size_t ws_size,
                              hipStream_t stream) {
  static int grid_blocks = 0;
  if (!grid_blocks) {
    int dev = 0, cus = 0, per_cu = 0;
    hipGetDevice(&dev);
    hipDeviceGetAttribute(&cus, hipDeviceAttributeMultiprocessorCount, dev);
    hipFuncSetAttribute((const void*)mega, hipFuncAttributeMaxDynamicSharedMemorySize, SMEM_BYTES);
    hipOccupancyMaxActiveBlocksPerMultiprocessor(&per_cu, mega, 256, SMEM_BYTES);
    if (per_cu < 1) per_cu = 1;
    if (per_cu > 2) per_cu = 2;
    grid_blocks = cus * per_cu;
    if (ws_size < WS_TOTAL) fprintf(stderr, "workspace too small: %zu < %zu\n", ws_size, (size_t)WS_TOTAL);
  }
  Params p{};
  p.x = (const float*)d_in[0]; p.mem = (const float*)d_in[1]; p.norm_g = (const float*)d_in[2]; p.w_in = (const float*)d_in[3];
  p.q_norm_g = (const float*)d_in[4]; p.w_uq = (const float*)d_in[5]; p.kv_norm_g = (const float*)d_in[6]; p.w_ukv = (const float*)d_in[7];
  p.cmp_pe_k = (const float*)d_in[8]; p.cmp_pe_v = (const float*)d_in[9]; p.cmp_w1k = (const float*)d_in[10]; p.cmp_w2k = (const float*)d_in[11];
  p.cmp_w1v = (const float*)d_in[12]; p.cmp_w2v = (const float*)d_in[13]; p.mem_norm_g = (const float*)d_in[14]; p.w_mem_kv = (const float*)d_in[15];
  p.w_out = (const float*)d_in[16]; p.final_g = (const float*)d_in[17];
  p.out = (float*)d_out; p.ws = (char*)d_ws;
  hipMemsetAsync((char*)d_ws + O_CTR, 0, CTR_BYTES, stream);
#if MULTI_LAUNCH
  for (int ph = 0; ph <= 6; ++ph) {
    p.phase_lo = ph; p.phase_hi = ph;
    hipLaunchKernelGGL(mega, dim3(grid_blocks), dim3(256), SMEM_BYTES, stream, p);
  }
#else
  p.phase_lo = 0; p.phase_hi = 6;
  void* args[] = {&p};
  hipError_t e = hipLaunchCooperativeKernel((void*)mega, dim3(grid_blocks), dim3(256), args, SMEM_BYTES, stream);
  if (e != hipSuccess) fprintf(stderr, "cooperative launch failed: %s (grid %d)\n", hipGetErrorString(e), grid_blocks);
#endif
}
```

```cpp
#include <hip/hip_runtime.h>
#include <hip/hip_cooperative_groups.h>
#include <stdint.h>
#include <cstdio>
namespace cg = cooperative_groups;

typedef unsigned short bfu;
typedef __attribute__((ext_vector_type(8))) short bf16x8;
typedef __attribute__((ext_vector_type(4))) float f32x4;
typedef __attribute__((ext_vector_type(16))) float f32x16;
typedef __attribute__((ext_vector_type(2))) __bf16 bf2_t;
typedef __attribute__((ext_vector_type(4))) unsigned u32x4;
#define DI __device__ __forceinline__

#ifndef MULTI_LAUNCH
#define MULTI_LAUNCH 0
#endif

constexpr int SEQ = 4096, NTOK = 16384, DM = 2048, DIN = 5388, DINP = 5632;
constexpr float EPS = 1e-6f;
constexpr float LOG2E = 1.4426950408889634f;
constexpr int NTHR = 512;
constexpr int SMEM_BYTES = 131072 + 256;

constexpr size_t al(size_t x) { return (x + 255) & ~size_t(255); }
constexpr size_t O_WT_IN  = 0;
constexpr size_t O_WT_MKV = O_WT_IN  + (size_t)DINP * 2048 * 2;
constexpr size_t O_WT_UQ  = O_WT_MKV + (size_t)1024 * 2048 * 2;
constexpr size_t O_WT_UKV = O_WT_UQ  + (size_t)1536 * 512 * 2;
constexpr size_t O_WT_C1K = O_WT_UKV + al((size_t)2048 * 512 * 2);
constexpr size_t O_WT_C1V = O_WT_C1K + al((size_t)256 * 6144 * 2);
constexpr size_t O_WT_C2K = O_WT_C1V + al((size_t)128 * 4096 * 2);
constexpr size_t O_WT_C2V = O_WT_C2K + al((size_t)256 * 192 * 2);
constexpr size_t O_WT_OUT = O_WT_C2V + al((size_t)128 * 128 * 2);
constexpr size_t O_BIASK  = O_WT_OUT + al((size_t)2048 * 2048 * 2);
constexpr size_t O_BIASV  = O_BIASK  + al((size_t)32 * 256 * 4);
constexpr size_t O_COS    = O_BIASV  + al((size_t)32 * 256 * 4);
constexpr size_t O_SIN    = O_COS    + al((size_t)4096 * 32 * 4);
constexpr size_t O_XN     = O_SIN    + al((size_t)4096 * 32 * 4);
constexpr size_t O_MEMN   = O_XN     + (size_t)NTOK * 2048 * 2;
constexpr size_t O_CQ     = O_MEMN   + al((size_t)1024 * 2048 * 2);
constexpr size_t O_CKV    = O_CQ     + (size_t)NTOK * 512 * 2;
constexpr size_t O_KPER   = O_CKV    + al((size_t)NTOK * 512 * 2);
constexpr size_t O_KPE    = O_KPER   + al((size_t)NTOK * 64 * 2);
constexpr size_t O_ZS     = O_KPE    + al((size_t)NTOK * 64 * 2);
constexpr size_t O_QNSA   = O_ZS     + al((size_t)NTOK * 2048 * 2);
constexpr size_t O_KC     = O_QNSA   + al((size_t)NTOK * 768 * 2);
constexpr size_t O_VC     = O_KC     + al((size_t)(NTOK + 64) * 192 * 2);
constexpr size_t O_KS     = O_VC     + al((size_t)(NTOK + 64) * 128 * 2);
constexpr size_t O_VS     = O_KS     + al((size_t)NTOK * 192 * 2);
constexpr size_t O_KW     = O_VS     + al((size_t)NTOK * 128 * 2);
constexpr size_t O_VW     = O_KW     + al((size_t)NTOK * 192 * 2);
constexpr size_t O_GATES  = O_VW     + al((size_t)NTOK * 128 * 2);
constexpr size_t O_QMEM   = O_GATES  + al((size_t)NTOK * 16 * 4);
constexpr size_t O_QMLA   = O_QMEM   + al((size_t)NTOK * 512 * 2);
constexpr size_t O_KNOPE  = O_QMLA   + al((size_t)NTOK * 1536 * 2);
constexpr size_t O_VMLA   = O_KNOPE  + al((size_t)NTOK * 1024 * 2);
constexpr size_t O_KCMP   = O_VMLA   + al((size_t)NTOK * 1024 * 2);
constexpr size_t O_VCMP   = O_KCMP   + al((size_t)1024 * 192 * 2);
constexpr size_t O_MEMK   = O_VCMP   + al((size_t)1024 * 128 * 2);
constexpr size_t O_MEMV   = O_MEMK   + al((size_t)1024 * 512 * 2);
constexpr size_t O_OCAT   = O_MEMV   + al((size_t)1024 * 512 * 2);
constexpr size_t O_ONSA   = O_OCAT   + al((size_t)NTOK * 2048 * 2);
constexpr size_t O_SSQP   = O_ONSA   + al((size_t)NTOK * 512 * 4);
constexpr size_t O_SSQ1   = O_SSQP   + al((size_t)NTOK * 32 * 4);
constexpr size_t O_PARTK  = O_SSQ1   + al((size_t)NTOK * 16 * 4);
constexpr size_t O_PARTV  = O_PARTK  + al((size_t)8 * 1024 * 256 * 4);
constexpr size_t O_CTR    = O_PARTV  + al((size_t)8 * 1024 * 128 * 4);
constexpr size_t CTR_BYTES = 16384 + 4096;
constexpr size_t O_Q      = O_CTR + 16384;
constexpr size_t WS_TOTAL = O_CTR    + CTR_BYTES;

struct Params {
  const float *x, *mem, *norm_g, *w_in, *q_norm_g, *w_uq, *kv_norm_g, *w_ukv, *cmp_pe_k, *cmp_pe_v,
              *cmp_w1k, *cmp_w2k, *cmp_w1v, *cmp_w2v, *mem_norm_g, *w_mem_kv, *w_out, *final_g;
  float* out;
  char* ws;
  int phase_lo, phase_hi;
};

__constant__ float INVF[32] = {1.000000000e+00f, 7.498942093e-01f, 5.623413252e-01f, 4.216965034e-01f, 3.162277660e-01f, 2.371373706e-01f, 1.778279410e-01f, 1.333521432e-01f, 1.000000000e-01f, 7.498942093e-02f, 5.623413252e-02f, 4.216965034e-02f, 3.162277660e-02f, 2.371373706e-02f, 1.778279410e-02f, 1.333521432e-02f, 1.000000000e-02f, 7.498942093e-03f, 5.623413252e-03f, 4.216965034e-03f, 3.162277660e-03f, 2.371373706e-03f, 1.778279410e-03f, 1.333521432e-03f, 1.000000000e-03f, 7.498942093e-04f, 5.623413252e-04f, 4.216965034e-04f, 3.162277660e-04f, 2.371373706e-04f, 1.778279410e-04f, 1.333521432e-04f};

DI unsigned pk2(float a, float b) { bf2_t v; v[0] = (__bf16)a; v[1] = (__bf16)b; return __builtin_bit_cast(unsigned, v); }
DI bfu f2b(float a) { return __builtin_bit_cast(unsigned short, (__bf16)a); }
DI float blo(unsigned v) { return __uint_as_float(v << 16); }
DI float bhi(unsigned v) { return __uint_as_float(v & 0xffff0000u); }
DI float siluf(float z) { return z * __builtin_amdgcn_rcpf(1.f + __expf(-z)); }
DI float sigmf(float z) { return __builtin_amdgcn_rcpf(1.f + __expf(-z)); }
DI int otid() { int t = threadIdx.x; asm volatile("" : "+v"(t)); return t; }
DI float wave_sum(float v) {
#pragma unroll
  for (int o = 32; o >= 1; o >>= 1) v += __shfl_xor(v, o);
  return v;
}
DI float xhalf_max(float v) {
  auto rr = __builtin_amdgcn_permlane32_swap(__float_as_uint(v), __float_as_uint(v), false, false);
  return fmaxf(__uint_as_float(rr[0]), __uint_as_float(rr[1]));
}
DI float xhalf_sum(float v) {
  auto rr = __builtin_amdgcn_permlane32_swap(__float_as_uint(v), __float_as_uint(v), false, false);
  return __uint_as_float(rr[0]) + __uint_as_float(rr[1]);
}

#define XB_TMO      128
#define XB_XCNT(j)  (256  + 64 * (j))
#define XB_XSUB(j)  (1280 + 64 * (j))
#define XB_XGEN(j)  (2304 + 64 * (j))
#define XB_TOP      3328
#define XB_TOPGEN   3392
#define XCD_BAR_WORDS 3456
#define XB_SPIN_CAP (1u << 18)
#define LAS __attribute__((address_space(3)))
DI unsigned xb_ld(unsigned* p)              { return __hip_atomic_load(p, __ATOMIC_RELAXED, __HIP_MEMORY_SCOPE_AGENT); }
DI unsigned xb_add(unsigned* p, unsigned v) { return __hip_atomic_fetch_add(p, v, __ATOMIC_RELAXED, __HIP_MEMORY_SCOPE_AGENT); }
DI unsigned xb_xcc_id() { return (unsigned)__builtin_amdgcn_s_getreg((3 << 11) | 20) & 0xFu; }
#define XB_SPIN(cond, bar) do { unsigned _sp = 0; while (cond) { __builtin_amdgcn_s_sleep(1); \
    if ((++_sp & 255u) == 0u) { if (xb_ld(&(bar)[XB_TMO])) break; if (_sp > XB_SPIN_CAP) { atomicAdd(&(bar)[XB_TMO], 1u); break; } } } } while (0)
struct XcdBarrier { unsigned* bar; unsigned x; volatile LAS unsigned* st; };
DI XcdBarrier xcd_barrier_post(unsigned* bar, volatile LAS unsigned* st) {
  XcdBarrier b; b.bar = bar; b.x = xb_xcc_id(); b.st = st;
  if (threadIdx.x == 0) (void)xb_add(&bar[XB_XCNT(b.x)], 1u);
  return b;
}
DI void xcd_barrier_complete(unsigned* bar, unsigned x, unsigned& nloc, unsigned& nx) {
  const unsigned G = gridDim.x * gridDim.y * gridDim.z;
  unsigned sum, cnt, mine, sp = 0u;
  for (;;) {
    sum = 0u; cnt = 0u; mine = 0u;
#pragma unroll
    for (unsigned j = 0; j < 16; ++j) { const unsigned c = xb_ld(&bar[XB_XCNT(j)]); sum += c; cnt += (c > 0u) ? 1u : 0u; mine = (j == x) ? c : mine; }
    if (sum == G) break;
    __builtin_amdgcn_s_sleep(1);
    if ((++sp & 255u) == 0u) { if (xb_ld(&bar[XB_TMO])) break; if (sp > XB_SPIN_CAP) { atomicAdd(&bar[XB_TMO], 1u); break; } }
  }
  nloc = mine > 0u ? mine : 1u; nx = cnt > 0u ? cnt : 1u;
}
DI void xcd_barrier(const XcdBarrier& b) {
  asm volatile("s_waitcnt vmcnt(0)" ::: "memory");
  __syncthreads();
  if (threadIdx.x == 0) {
    unsigned* bar = b.bar;
    __builtin_amdgcn_s_waitcnt(0);
    unsigned nloc = b.st[0], nx = b.st[1];
    if (nloc == 0u) { xcd_barrier_complete(bar, b.x, nloc, nx); b.st[0] = nloc; b.st[1] = nx; }
    const unsigned old = xb_add(&bar[XB_XSUB(b.x)], 1u);
    const unsigned gen = old / nloc;
    if (old + 1u == (gen + 1u) * nloc) {
      __builtin_amdgcn_fence(__ATOMIC_RELEASE, "agent");
      asm volatile("s_waitcnt vmcnt(0)" ::: "memory");
      const unsigned og = xb_add(&bar[XB_TOP], 1u);
      const unsigned tg = og / nx;
      if (og + 1u == (tg + 1u) * nx) xb_add(&bar[XB_TOPGEN], 1u);
      else XB_SPIN(xb_ld(&bar[XB_TOPGEN]) == tg, bar);
      __builtin_amdgcn_fence(__ATOMIC_ACQUIRE, "agent");
      xb_add(&bar[XB_XGEN(b.x)], 1u);
      asm volatile("s_waitcnt vmcnt(0)" ::: "memory");
    } else {
      XB_SPIN(xb_ld(&bar[XB_XGEN(b.x)]) == gen, bar);
      __builtin_amdgcn_fence(__ATOMIC_ACQUIRE, "agent");
      asm volatile("s_waitcnt vmcnt(0)" ::: "memory");
    }
  }
  __syncthreads();
}

namespace pg8 {
#define PG8_LAS __attribute__((address_space(3)))
typedef unsigned short bf16_t;
constexpr int BM = 256, BK = 64, HALF = 128, HTB = HALF * BK * 2, STAGE_BYTES = 8 * HTB, NXCD = 8, WGM = 8;
__host__ __device__ __forceinline__ int lds_byte(int r, int c) { const int st = (r >> 4) * 2 + (c >> 5), rr = r & 15, cc = c & 31, ob = rr * 64 + cc * 2; return st * 1024 + (ob ^ (((ob >> 9) & 1) << 5)); }
__host__ __device__ __forceinline__ void stage_rc(int b, int& R, int& C) { const int st = b / 1024, sb = b % 1024, swz = sb ^ (((sb >> 9) & 1) << 5); R = (st >> 1) * 16 + swz / 64; C = (st & 1) * 32 + (swz % 64) / 2; }
__host__ __device__ __forceinline__ int perm32(int rho) { const int n = rho >> 4, i = rho & 15; return 8 * (i >> 2) + 4 * n + (i & 3); }
struct Unit { int pm, pn; };
struct Gemm { const bf16_t* A; const bf16_t* Bt; int M, N, K; };
struct Sched2 {
  int G, c, nM1, nN1, nM2, nN2, pmo2, pno2;
  __device__ bool next(int i, Unit& u) const {
    const int n1 = nM1 * nN1, total = n1 + nM2 * nN2;
    const long L = (long)i * G + c; if (L >= total) return false;
    if (L < n1) {
      int wgid = (int)L; { const int q = n1 / NXCD, r = n1 % NXCD, xcd = wgid % NXCD, off = wgid / NXCD; wgid = (xcd < r ? xcd * (q + 1) : r * (q + 1) + (xcd - r) * q) + off; }
      const int nig = WGM * nN1, gid = wgid / nig, fm = gid * WGM, gsz = (nM1 - fm) < WGM ? (nM1 - fm) : WGM;
      u.pm = fm + ((wgid % nig) % gsz); u.pn = (wgid % nig) / gsz;
    } else { const int r = (int)L - n1; u.pm = pmo2 + r / nN2; u.pn = pno2 + r % nN2; }
    return true;
  }
  __device__ __forceinline__ void a_ready(const Unit&) const {}
  __device__ __forceinline__ void done(const Unit&) const {}
};
template <class Epi, class Sched>
__device__ __forceinline__ void gemm_phase(PG8_LAS unsigned char* lds, const Gemm g, const Sched& S, const Epi& E) {
    const int tid = otid(), wid = __builtin_amdgcn_readfirstlane(tid >> 6), lane = tid & 63, wr = wid >> 2, wc = wid & 3, fr = lane & 15, fq = lane >> 4;
    const int K = g.K, nt = K / BK;
    unsigned voffA[2], voffB[2];
#pragma unroll
    for (int i = 0; i < 2; ++i) { int R, C; stage_rc(tid * 16 + i * 8192, R, C); const int Rb = Epi::PERM ? ((R & ~31) + perm32(R & 31)) : R;
        voffA[i] = (unsigned)(R * K + C) * 2u; voffB[i] = (unsigned)(Rb * K + C) * 2u; }
    const size_t kstep = (size_t)(BK * 2);
    const size_t hstep = (size_t)HALF * K * 2;
    const size_t tstep = 2 * hstep;
    const unsigned ldsw = (unsigned)wid * 1024u;
    const int aoff = lds_byte(wr * 64 + fr, fq * 8), boff = lds_byte(wc * 32 + fr, fq * 8);
#define PG8_SA(b, h) (((b) * 2 + (h)) * HTB)
#define PG8_SB(b, h) ((4 + (b) * 2 + (h)) * HTB)
#define PG8_STAGE(bufoff, gbase, voff) do { _Pragma("unroll") for (int _i = 0; _i < 2; ++_i) \
        __builtin_amdgcn_global_load_lds((const unsigned*)((const char*)(gbase) + (voff)[_i]), (PG8_LAS unsigned*)(lds + (bufoff) + ldsw + _i * 8192), 16, 0, 0); } while (0)
#define PG8_LDA(dst, b, h) do { _Pragma("unroll") for (int m = 0; m < 4; ++m) _Pragma("unroll") for (int k = 0; k < 2; ++k) dst[m][k] = *(const PG8_LAS bf16x8*)(lds + PG8_SA(b, h) + aoff + m * 2048 + k * 1024); } while (0)
#define PG8_LDB(dst, b, h) do { _Pragma("unroll") for (int n = 0; n < 2; ++n) _Pragma("unroll") for (int k = 0; k < 2; ++k) dst[n][k] = *(const PG8_LAS bf16x8*)(lds + PG8_SB(b, h) + boff + n * 2048 + k * 1024); } while (0)
#define PG8_MMA(ai, bj, At, Bt) do { __builtin_amdgcn_s_setprio(1); _Pragma("unroll") for (int m = 0; m < 4; ++m) _Pragma("unroll") for (int n = 0; n < 2; ++n) _Pragma("unroll") for (int k = 0; k < 2; ++k) \
        acc[ai][bj][m][n] = __builtin_amdgcn_mfma_f32_16x16x32_bf16(Bt[n][k], At[m][k], acc[ai][bj][m][n], 0, 0, 0); __builtin_amdgcn_s_setprio(0); } while (0)
#define PG8_WAIT_V(n) asm volatile("s_waitcnt vmcnt(" #n ")" ::: "memory")
#define PG8_WAIT_L(n) asm volatile("s_waitcnt lgkmcnt(" #n ")" ::: "memory")
#define PG8_BAR __builtin_amdgcn_s_barrier()
#define PG8_SCHED __builtin_amdgcn_sched_barrier(0)
    Unit cur, nxt; int ui = 0;
    if (!S.next(0, cur)) return;
    f32x4 acc[2][2][4][2];
#pragma unroll
    for (int a = 0; a < 2; ++a)
#pragma unroll
        for (int b = 0; b < 2; ++b)
#pragma unroll
            for (int m = 0; m < 4; ++m)
#pragma unroll
                for (int n = 0; n < 2; ++n) acc[a][b][m][n] = (f32x4){0.f, 0.f, 0.f, 0.f};
    bf16x8 At[4][2], B0[2][2], B1[2][2];
    const char* cA = (const char*)g.A + (size_t)cur.pm * tstep; const char* cB = (const char*)g.Bt + (size_t)cur.pn * tstep;
    S.a_ready(cur);
    PG8_STAGE(PG8_SB(0, 0), cB, voffB); PG8_STAGE(PG8_SA(0, 0), cA, voffA); PG8_STAGE(PG8_SB(0, 1), cB + hstep, voffB); PG8_STAGE(PG8_SA(0, 1), cA + hstep, voffA);
    if (wr == 1) PG8_BAR;
    PG8_WAIT_V(4); PG8_BAR;
    PG8_STAGE(PG8_SB(1, 0), cB + kstep, voffB); PG8_STAGE(PG8_SA(1, 0), cA + kstep, voffA); PG8_STAGE(PG8_SB(1, 1), cB + hstep + kstep, voffB);
    PG8_WAIT_V(6); PG8_BAR;
    for (;;) {
        const bool has_next = S.next(ui + 1, nxt);
        const char* nA = has_next ? (const char*)g.A + (size_t)nxt.pm * tstep : cA; const char* nB = has_next ? (const char*)g.Bt + (size_t)nxt.pn * tstep : cB;
        for (int t = 0; t < nt; t += 2) {
            const bool last = (t == nt - 2);
            const char* a1 = cA + (size_t)(t + 1) * kstep;
            const char* a2 = last ? nA : cA + (size_t)(t + 2) * kstep; const char* b2 = last ? nB : cB + (size_t)(t + 2) * kstep;
            const char* a3 = a2 + kstep; const char* b3 = b2 + kstep;
            if (last && has_next) S.a_ready(nxt);
            PG8_LDB(B0, 0, 0); PG8_SCHED; PG8_LDA(At, 0, 0); PG8_STAGE(PG8_SA(1, 1), a1 + hstep, voffA);
            PG8_WAIT_L(8); PG8_BAR; PG8_WAIT_L(0); PG8_MMA(0, 0, At, B0); PG8_BAR; PG8_SCHED;
            PG8_LDB(B1, 0, 1); PG8_STAGE(PG8_SB(0, 0), b2, voffB);
            PG8_BAR; PG8_WAIT_L(0); PG8_MMA(0, 1, At, B1); PG8_BAR;
            PG8_LDA(At, 0, 1); PG8_STAGE(PG8_SA(0, 0), a2, voffA);
            PG8_BAR; PG8_WAIT_L(0); PG8_MMA(1, 0, At, B0); PG8_BAR; PG8_SCHED;
            PG8_STAGE(PG8_SB(0, 1), b2 + hstep, voffB);
            PG8_WAIT_V(6); PG8_BAR; PG8_MMA(1, 1, At, B1); PG8_BAR;
            PG8_LDB(B0, 1, 0); PG8_SCHED; PG8_LDA(At, 1, 0); PG8_STAGE(PG8_SA(0, 1), a2 + hstep, voffA);
            PG8_WAIT_L(8); PG8_BAR; PG8_WAIT_L(0); PG8_MMA(0, 0, At, B0); PG8_BAR; PG8_SCHED;
            PG8_LDB(B1, 1, 1); PG8_STAGE(PG8_SB(1, 0), b3, voffB);
            PG8_BAR; PG8_WAIT_L(0); PG8_MMA(0, 1, At, B1); PG8_BAR;
            PG8_LDA(At, 1, 1); PG8_STAGE(PG8_SA(1, 0), a3, voffA);
            PG8_BAR; PG8_WAIT_L(0); PG8_MMA(1, 0, At, B0); PG8_BAR; PG8_SCHED;
            PG8_STAGE(PG8_SB(1, 1), b3 + hstep, voffB);
            PG8_WAIT_V(6); PG8_BAR; PG8_MMA(1, 1, At, B1); PG8_BAR;
        }
        if constexpr (!Epi::AFTER_DRAIN) { E(acc, cur, wr, wc, fr, fq); S.done(cur); }
        if (!has_next) break;
#pragma unroll
        for (int a = 0; a < 2; ++a)
#pragma unroll
            for (int b = 0; b < 2; ++b)
#pragma unroll
                for (int m = 0; m < 4; ++m)
#pragma unroll
                    for (int n = 0; n < 2; ++n) acc[a][b][m][n] = (f32x4){0.f, 0.f, 0.f, 0.f};
        cur = nxt; cA = nA; cB = nB; ++ui;
    }
    PG8_WAIT_V(0);
    if (wr == 0) PG8_BAR;
    PG8_BAR;
    if constexpr (Epi::AFTER_DRAIN) { E.fused(acc, cur, wr, wc, fr, fq, lds, wid, lane); S.done(cur); }
#undef PG8_SA
#undef PG8_SB
#undef PG8_STAGE
#undef PG8_LDA
#undef PG8_LDB
#undef PG8_MMA
#undef PG8_WAIT_V
#undef PG8_WAIT_L
#undef PG8_BAR
#undef PG8_SCHED
}

}

DI void st8(bfu* p, const f32x4& v0, const f32x4& v1, float sc) {
  *(uint4*)p = make_uint4(pk2(v0[0] * sc, v0[1] * sc), pk2(v0[2] * sc, v0[3] * sc), pk2(v1[0] * sc, v1[1] * sc), pk2(v1[2] * sc, v1[3] * sc));
}
DI void st8silu(bfu* p, const f32x4& v0, const f32x4& v1) {
  *(uint4*)p = make_uint4(pk2(siluf(v0[0]), siluf(v0[1])), pk2(siluf(v0[2]), siluf(v0[3])), pk2(siluf(v1[0]), siluf(v1[1])), pk2(siluf(v1[2]), siluf(v1[3])));
}
struct EpiP1 {
  static constexpr bool PERM = true, AFTER_DRAIN = false;
  char* ws;
  DI void operator()(const f32x4 (&acc)[2][2][4][2], const pg8::Unit& u, int wr, int wc, int fr, int fq) const {
    if (u.pm >= 64) {
      const int row0 = (u.pm - 64) * 256 + 64 * wr + fr;
#pragma unroll
      for (int bj = 0; bj < 2; ++bj) {
        const int col = (u.pn - 22) * 256 + 128 * bj + 32 * wc + 8 * fq;
        bfu* dst = (col < 512) ? (bfu*)(ws + O_MEMK) + col : (bfu*)(ws + O_MEMV) + (col - 512);
#pragma unroll
        for (int ai = 0; ai < 2; ++ai)
#pragma unroll
          for (int m = 0; m < 4; ++m) st8(dst + (long)(row0 + 128 * ai + 16 * m) * 512, acc[ai][bj][m][0], acc[ai][bj][m][1], 1.f);
      }
      return;
    }
    const int row0 = u.pm * 256 + 64 * wr + fr;
    float ss[2][4];
#pragma unroll
    for (int ai = 0; ai < 2; ++ai)
#pragma unroll
      for (int m = 0; m < 4; ++m) ss[ai][m] = 0.f;
#pragma unroll
    for (int bj = 0; bj < 2; ++bj) {
      const int c32 = 256 * u.pn + 128 * bj + 32 * wc;
      const int col = c32 + 8 * fq;
      bfu* dst = nullptr; int ld = 0; int kind = 0; float sc = 1.f;
      if (c32 < 512)       { dst = (bfu*)(ws + O_CQ) + col; ld = 512; }
      else if (c32 < 1024) { dst = (bfu*)(ws + O_CKV) + (col - 512); ld = 512; }
      else if (c32 < 1088) { dst = (bfu*)(ws + O_KPER) + (col - 1024); ld = 64; }
      else if (c32 < 2112) { dst = (bfu*)(ws + O_ZS) + (col - 1088); ld = 2048; kind = 1; }
      else if (c32 < 2880) { dst = (bfu*)(ws + O_QNSA) + (col - 2112); ld = 768; sc = 0.07216878364870322f * LOG2E; }
      else if (c32 < 3072) { dst = (bfu*)(ws + O_KC) + (col - 2880); ld = 192; }
      else if (c32 < 3200) { dst = (bfu*)(ws + O_VC) + (col - 3072); ld = 128; }
      else if (c32 < 3392) { dst = (bfu*)(ws + O_KS) + (col - 3200); ld = 192; }
      else if (c32 < 3520) { dst = (bfu*)(ws + O_VS) + (col - 3392); ld = 128; }
      else if (c32 < 3712) { dst = (bfu*)(ws + O_KW) + (col - 3520); ld = 192; }
      else if (c32 < 3840) { dst = (bfu*)(ws + O_VW) + (col - 3712); ld = 128; }
      else if (c32 < 3872) { kind = 2; }
      else if (c32 < 3968) { kind = 3; }
      else if (c32 < 4480) { dst = (bfu*)(ws + O_ZS) + (col - 3968 + 1024); ld = 2048; kind = 1; }
      else if (c32 < 4992) { dst = (bfu*)(ws + O_QMEM) + (col - 4480); ld = 512; sc = 0.08838834764831845f * LOG2E; }
      else if (c32 < 5504) { dst = (bfu*)(ws + O_ZS) + (col - 4992 + 1536); ld = 2048; kind = 1; }
      else { kind = 3; }
      if (kind == 3) continue;
#pragma unroll
      for (int ai = 0; ai < 2; ++ai)
#pragma unroll
        for (int m = 0; m < 4; ++m) {
          const long row = row0 + 128 * ai + 16 * m;
          const f32x4 v0 = acc[ai][bj][m][0], v1 = acc[ai][bj][m][1];
          if (kind == 0) {
            st8(dst + row * ld, v0, v1, sc);
            if (c32 < 1024) ss[ai][m] += v0[0] * v0[0] + v0[1] * v0[1] + v0[2] * v0[2] + v0[3] * v0[3] + v1[0] * v1[0] + v1[1] * v1[1] + v1[2] * v1[2] + v1[3] * v1[3];
          } else if (kind == 1) {
            st8silu(dst + row * ld, v0, v1);
          } else {
            float* g = (float*)(ws + O_GATES) + row * 16;
            if (fq == 0) { *(float4*)g = make_float4(sigmf(v0[0]), sigmf(v0[1]), sigmf(v0[2]), sigmf(v0[3])); *(float4*)(g + 4) = make_float4(sigmf(v1[0]), sigmf(v1[1]), sigmf(v1[2]), sigmf(v1[3])); }
            else if (fq == 1) { *(float4*)(g + 8) = make_float4(sigmf(v0[0]), sigmf(v0[1]), sigmf(v0[2]), sigmf(v0[3])); }
          }
        }
    }
    if (u.pn < 4) {
#pragma unroll
      for (int ai = 0; ai < 2; ++ai)
#pragma unroll
        for (int m = 0; m < 4; ++m) {
          float v = ss[ai][m];
          v += __shfl_xor(v, 16); v += __shfl_xor(v, 32);
          if (fq == 0) ((float*)(ws + O_SSQ1))[(long)(row0 + 128 * ai + 16 * m) * 16 + u.pn * 4 + wc] = v;
        }
    }
  }
};
struct EpiP2 {
  static constexpr bool PERM = true, AFTER_DRAIN = false;
  char* ws;
  DI void operator()(const f32x4 (&acc)[2][2][4][2], const pg8::Unit& u, int wr, int wc, int fr, int fq) const {
    const bool isq = u.pm < 64;
    const int row0 = (isq ? u.pm : u.pm - 64) * 256 + 64 * wr + fr;
    const float* sp = (const float*)(ws + O_SSQ1) + (isq ? 0 : 8);
#pragma unroll
    for (int ai = 0; ai < 2; ++ai)
#pragma unroll
      for (int m = 0; m < 4; ++m) {
        const long row = row0 + 128 * ai + 16 * m;
        const float4 a = *(const float4*)(sp + row * 16), b = *(const float4*)(sp + row * 16 + 4);
        const float rstd = rsqrtf((a.x + a.y + a.z + a.w + b.x + b.y + b.z + b.w) * (1.f / 512.f) + EPS);
#pragma unroll
        for (int bj = 0; bj < 2; ++bj) {
          if (isq) {
            const int col = 256 * u.pn + 128 * bj + 32 * wc + 8 * fq;
            st8((bfu*)(ws + O_QMLA) + row * 1536 + col, acc[ai][bj][m][0], acc[ai][bj][m][1], rstd * (0.07216878364870322f * LOG2E));
          } else {
            const int head = u.pn - 6, within = 32 * wc + 8 * fq;
            bfu* dst = (bj == 0) ? (bfu*)(ws + O_KNOPE) : (bfu*)(ws + O_VMLA);
            st8(dst + row * 1024 + head * 128 + within, acc[ai][bj][m][0], acc[ai][bj][m][1], rstd);
          }
        }
      }
  }
};
struct EpiP5 {
  static constexpr bool PERM = false, AFTER_DRAIN = false;
  const float* x; float* out; float* ssqp;
  DI void operator()(const f32x4 (&acc)[2][2][4][2], const pg8::Unit& u, int wr, int wc, int fr, int fq) const {
    const int row0 = u.pm * 256 + 64 * wr + fr, col0 = u.pn * 256 + 32 * wc + 4 * fq;
#pragma unroll
    for (int ai = 0; ai < 2; ++ai)
#pragma unroll
      for (int m = 0; m < 4; ++m) {
        const long off = (long)(row0 + 128 * ai + 16 * m) * DM + col0;
        float ss = 0.f;
#pragma unroll
        for (int bj = 0; bj < 2; ++bj)
#pragma unroll
          for (int n = 0; n < 2; ++n) {
            const float4 xv = *(const float4*)(x + off + 128 * bj + 16 * n);
            const f32x4 a = acc[ai][bj][m][n];
            const float4 y = make_float4(a[0] + xv.x, a[1] + xv.y, a[2] + xv.z, a[3] + xv.w);
            *(float4*)(out + off + 128 * bj + 16 * n) = y;
            ss += y.x * y.x + y.y * y.y + y.z * y.z + y.w * y.w;
          }
        ss += __shfl_xor(ss, 16); ss += __shfl_xor(ss, 32);
        if (fq == 0) ssqp[(long)(row0 + 128 * ai + 16 * m) * 32 + u.pn * 4 + wc] = ss;
      }
  }
};

DI uint4 psum_load(const float* part, int N, int row, int k) {
  float v[8] = {0.f, 0.f, 0.f, 0.f, 0.f, 0.f, 0.f, 0.f};
#pragma unroll
  for (int c = 0; c < 8; ++c) {
    const float4* p = (const float4*)(part + ((long)c * 1024 + row) * N + k);
    float4 a = p[0], b = p[1];
    v[0] += a.x; v[1] += a.y; v[2] += a.z; v[3] += a.w; v[4] += b.x; v[5] += b.y; v[6] += b.z; v[7] += b.w;
  }
  return make_uint4(pk2(siluf(v[0]), siluf(v[1])), pk2(siluf(v[2]), siluf(v[3])), pk2(siluf(v[4]), siluf(v[5])), pk2(siluf(v[6]), siluf(v[7])));
}
constexpr int G_LD = 72;
template <bool PSUM, class Epi>
DI void gemm_tile(const bfu* __restrict__ A, long lda, const bfu* __restrict__ Bt, long ldb, int K, int row0, int col0, const Epi& epi, char* smem) {
  bfu* sA = (bfu*)smem;
  bfu* sB = sA + 2 * 128 * G_LD;
  const int tid = otid(), lane = tid & 63, wave = tid >> 6;
  const int wm = wave >> 1, wn = wave & 1, l15 = lane & 15, quad = lane >> 4;
  const int srow = tid >> 3, skc = tid & 7;
  const bfu* ga = PSUM ? A : A + (long)(row0 + srow) * lda + skc * 8;
  const bfu* gb = Bt + (long)(col0 + srow) * ldb + skc * 8;
  f32x4 acc[2][4];
#pragma unroll
  for (int i = 0; i < 2; ++i)
#pragma unroll
    for (int j = 0; j < 4; ++j) acc[i][j] = f32x4{0.f, 0.f, 0.f, 0.f};
  uint4 ra[2], rb[2];
  const int nk = K >> 6;
#pragma unroll
  for (int i = 0; i < 2; ++i) {
    if (PSUM) ra[i] = psum_load((const float*)A, (int)lda, row0 + srow + 64 * i, skc * 8); else ra[i] = *(const uint4*)(ga + (long)(64 * i) * lda);
    rb[i] = *(const uint4*)(gb + (long)(64 * i) * ldb);
  }
#pragma unroll
  for (int i = 0; i < 2; ++i) {
    *(uint4*)(sA + (srow + 64 * i) * G_LD + skc * 8) = make_uint4(ra[i].x, ra[i].y, ra[i].z, ra[i].w);
    *(uint4*)(sB + (srow + 64 * i) * G_LD + skc * 8) = make_uint4(rb[i].x, rb[i].y, rb[i].z, rb[i].w);
  }
  __syncthreads();
  for (int kt = 0; kt < nk; ++kt) {
    const int buf = kt & 1;
    const bool more = (kt + 1 < nk);
    if (more) {
#pragma unroll
      for (int i = 0; i < 2; ++i) {
        if (PSUM) ra[i] = psum_load((const float*)A, (int)lda, row0 + srow + 64 * i, skc * 8 + (kt + 1) * 64); else ra[i] = *(const uint4*)(ga + (long)(64 * i) * lda + (kt + 1) * 64);
        rb[i] = *(const uint4*)(gb + (long)(64 * i) * ldb + (kt + 1) * 64);
      }
    }
    const bfu* pa = sA + buf * 128 * G_LD + (wm * 32 + l15) * G_LD + quad * 8;
    const bfu* pb = sB + buf * 128 * G_LD + (wn * 64 + l15) * G_LD + quad * 8;
#pragma unroll
    for (int ks = 0; ks < 2; ++ks) {
      bf16x8 a[2], b[4];
#pragma unroll
      for (int i = 0; i < 2; ++i) a[i] = *(const bf16x8*)(pa + i * 16 * G_LD + ks * 32);
#pragma unroll
      for (int i = 0; i < 4; ++i) b[i] = *(const bf16x8*)(pb + i * 16 * G_LD + ks * 32);
#pragma unroll
      for (int i = 0; i < 2; ++i)
#pragma unroll
        for (int j = 0; j < 4; ++j) acc[i][j] = __builtin_amdgcn_mfma_f32_16x16x32_bf16(a[i], b[j], acc[i][j], 0, 0, 0);
    }
    if (more) {
      const int nb = buf ^ 1;
#pragma unroll
      for (int i = 0; i < 2; ++i) {
        *(uint4*)(sA + nb * 128 * G_LD + (srow + 64 * i) * G_LD + skc * 8) = make_uint4(ra[i].x, ra[i].y, ra[i].z, ra[i].w);
        *(uint4*)(sB + nb * 128 * G_LD + (srow + 64 * i) * G_LD + skc * 8) = make_uint4(rb[i].x, rb[i].y, rb[i].z, rb[i].w);
      }
    }
    __syncthreads();
  }
#pragma unroll
  for (int mi = 0; mi < 2; ++mi) epi(row0 + wm * 32 + mi * 16 + quad * 4, col0 + wn * 64, l15, acc[mi]);
}
struct EpiC1 {
  const float* biasp; float* dst; int N; int chunk;
  DI void operator()(int r4, int c0, int l15, const f32x4 (&a)[4]) const {
#pragma unroll
    for (int ni = 0; ni < 4; ++ni) {
      int n = c0 + ni * 16 + l15;
      if (n < N) {
        float bsum = 0.f;
#pragma unroll
        for (int ch = 0; ch < 4; ++ch) bsum += biasp[(chunk * 4 + ch) * 256 + n];
#pragma unroll
        for (int j = 0; j < 4; ++j) dst[((long)chunk * 1024 + r4 + j) * N + n] = a[ni][j] + bsum;
      }
    }
  }
};
struct EpiC2 {
  bfu* dst; int N;
  DI void operator()(int r4, int c0, int l15, const f32x4 (&a)[4]) const {
#pragma unroll
    for (int ni = 0; ni < 4; ++ni) { int n = c0 + ni * 16 + l15;
      if (n < N) {
#pragma unroll
        for (int j = 0; j < 4; ++j) dst[(long)(r4 + j) * N + n] = f2b(a[ni][j]); } }
  }
};

DI void rms_row(const float* __restrict__ src, const float* __restrict__ g, bfu* __restrict__ dst, int lane) {
  const float4* s4 = (const float4*)src;
  float4 v[8]; float ss = 0.f;
#pragma unroll
  for (int i = 0; i < 8; ++i) { v[i] = s4[lane + 64 * i]; ss += v[i].x * v[i].x + v[i].y * v[i].y + v[i].z * v[i].z + v[i].w * v[i].w; }
  ss = wave_sum(ss);
  const float r = rsqrtf(ss * (1.f / 2048.f) + EPS);
#pragma unroll
  for (int i = 0; i < 8; ++i) {
    float4 gg = ((const float4*)g)[lane + 64 * i];
    uint2 o; o.x = pk2(v[i].x * r * gg.x, v[i].y * r * gg.y); o.y = pk2(v[i].z * r * gg.z, v[i].w * r * gg.w);
    *(uint2*)(dst + (lane + 64 * i) * 4) = o;
  }
}
DI void tr_tile2(const float* __restrict__ src, const float* __restrict__ g, bfu* __restrict__ dst, int K, int Nsrc,
                 int nvalid1, int nzero_end, int nshift, int ntn, int pair, float* smem_f) {
  const int tid5 = otid();
  const int half = tid5 >> 8, tid = tid5 & 255;
  const int tl = pair * 2 + half, kt = tl / ntn, nt = tl % ntn;
  float* tile = smem_f + half * (64 * 65);
  const int k0 = kt * 64, n0 = nt * 64;
  const int nn = (tid & 15) * 4, np = n0 + nn;
  int sn = (np < nvalid1) ? np : (np < nzero_end ? -1 : np - nshift);
  if (sn >= Nsrc) sn = -1;
#pragma unroll
  for (int i = 0; i < 4; ++i) {
    int kk = (tid >> 4) + 16 * i;
    float4 v = make_float4(0.f, 0.f, 0.f, 0.f);
    if (sn >= 0) {
      v = *(const float4*)(src + (long)(k0 + kk) * Nsrc + sn);
      if (g) { float gg = g[k0 + kk]; v.x *= gg; v.y *= gg; v.z *= gg; v.w *= gg; }
    }
    tile[kk * 65 + nn + 0] = v.x; tile[kk * 65 + nn + 1] = v.y; tile[kk * 65 + nn + 2] = v.z; tile[kk * 65 + nn + 3] = v.w;
  }
  __syncthreads();
  const int nn2 = tid >> 2, kseg = (tid & 3) * 16;
  unsigned w[8];
#pragma unroll
  for (int e = 0; e < 8; ++e) w[e] = pk2(tile[(kseg + 2 * e) * 65 + nn2], tile[(kseg + 2 * e + 1) * 65 + nn2]);
  bfu* d = dst + (long)(n0 + nn2) * K + k0 + kseg;
  *(uint4*)d = make_uint4(w[0], w[1], w[2], w[3]);
  *(uint4*)(d + 8) = make_uint4(w[4], w[5], w[6], w[7]);
  __syncthreads();
}

DI void phase0(const Params& P, char* smem) {
  char* ws = P.ws;
  float* tile = (float*)smem;
  constexpr int N_XN = 2048, N_MEMN = 128;
  constexpr int T_IN = 32 * 88 / 2, T_UQ = 8 * 24 / 2, T_UKV = 8 * 32 / 2, T_C1K = 96 * 4 / 2, T_C1V = 64 * 2 / 2, T_C2K = 3 * 4 / 2, T_C2V = 2 * 2 / 2, T_MKV = 32 * 16 / 2, T_OUT = 32 * 32 / 2;
  constexpr int N_CS = 256, N_BIAS = 64;
  constexpr int S1 = N_XN, S2 = S1 + N_MEMN, S3 = S2 + T_IN, S4 = S3 + T_UQ, S5 = S4 + T_UKV, S6 = S5 + T_C1K, S7 = S6 + T_C1V,
                S8 = S7 + T_C2K, S9 = S8 + T_C2V, S10 = S9 + T_MKV, S11 = S10 + T_OUT, S12 = S11 + N_CS, S13 = S12 + N_BIAS;
  for (int it = blockIdx.x; it < S13; it += gridDim.x) {
    const int tid = otid(), lane = tid & 63, wave = tid >> 6;
    if (it < S1) { int row = it * 8 + wave; rms_row(P.x + (long)row * DM, P.norm_g, (bfu*)(ws + O_XN) + (long)row * DM, lane); }
    else if (it < S2) { int row = (it - S1) * 8 + wave; rms_row(P.mem + (long)row * DM, P.mem_norm_g, (bfu*)(ws + O_MEMN) + (long)row * DM, lane); }
    else if (it < S3) tr_tile2(P.w_in, nullptr, (bfu*)(ws + O_WT_IN), 2048, DIN, 3852, 3968, 116, 88, it - S2, tile);
    else if (it < S4) tr_tile2(P.w_uq, P.q_norm_g, (bfu*)(ws + O_WT_UQ), 512, 1536, 1536, 1 << 30, 0, 24, it - S3, tile);
    else if (it < S5) tr_tile2(P.w_ukv, P.kv_norm_g, (bfu*)(ws + O_WT_UKV), 512, 2048, 2048, 1 << 30, 0, 32, it - S4, tile);
    else if (it < S6) tr_tile2(P.cmp_w1k, nullptr, (bfu*)(ws + O_WT_C1K), 6144, 192, 192, 1 << 30, 0, 4, it - S5, tile);
    else if (it < S7) tr_tile2(P.cmp_w1v, nullptr, (bfu*)(ws + O_WT_C1V), 4096, 128, 128, 1 << 30, 0, 2, it - S6, tile);
    else if (it < S8) tr_tile2(P.cmp_w2k, nullptr, (bfu*)(ws + O_WT_C2K), 192, 192, 192, 1 << 30, 0, 4, it - S7, tile);
    else if (it < S9) tr_tile2(P.cmp_w2v, nullptr, (bfu*)(ws + O_WT_C2V), 128, 128, 128, 1 << 30, 0, 2, it - S8, tile);
    else if (it < S10) tr_tile2(P.w_mem_kv, nullptr, (bfu*)(ws + O_WT_MKV), 2048, 1024, 1024, 1 << 30, 0, 16, it - S9, tile);
    else if (it < S11) tr_tile2(P.w_out, nullptr, (bfu*)(ws + O_WT_OUT), 2048, 2048, 2048, 1 << 30, 0, 32, it - S10, tile);
    else if (it < S12) {
      int idx = (it - S11) * NTHR + tid; int pos = idx >> 5, i = idx & 31;
      float ang = (float)pos * INVF[i];
      float rev = ang * 0.15915494309189535f;
      rev = rev - floorf(rev);
      ((float*)(ws + O_COS))[idx] = __builtin_amdgcn_cosf(rev);
      ((float*)(ws + O_SIN))[idx] = __builtin_amdgcn_sinf(rev);
    }
    else {
      int i = it - S12;
      if (i < 32) { if (tid < 192) { float acc = 0.f; for (int k = i * 192; k < (i + 1) * 192; ++k) acc += P.cmp_pe_k[k] * P.cmp_w1k[(long)k * 192 + tid]; ((float*)(ws + O_BIASK))[i * 256 + tid] = acc; } }
      else { int c = i - 32; if (tid < 128) { float acc = 0.f; for (int k = c * 128; k < (c + 1) * 128; ++k) acc += P.cmp_pe_v[k] * P.cmp_w1v[(long)k * 128 + tid]; ((float*)(ws + O_BIASV))[c * 256 + tid] = acc; } }
    }
  }
}
DI void kpe_rope_item(char* ws, int item) {
  const int tid = otid();
  const int tok = item * 256 + (tid >> 1), part = tid & 1, pos = tok & (SEQ - 1);
  const bfu* src = (const bfu*)(ws + O_KPER) + (long)tok * 64 + part * 16;
  bfu* dst = (bfu*)(ws + O_KPE) + (long)tok * 64 + part * 16;
  const float* cs = (const float*)(ws + O_COS) + pos * 32 + part * 16;
  const float* sn = (const float*)(ws + O_SIN) + pos * 32 + part * 16;
#pragma unroll
  for (int c = 0; c < 2; ++c) {
    const uint4 a = *(const uint4*)(src + c * 8), b = *(const uint4*)(src + 32 + c * 8);
    const float4 c0 = *(const float4*)(cs + c * 8), c1 = *(const float4*)(cs + c * 8 + 4), s0 = *(const float4*)(sn + c * 8), s1 = *(const float4*)(sn + c * 8 + 4);
    const float x1[8] = {blo(a.x), bhi(a.x), blo(a.y), bhi(a.y), blo(a.z), bhi(a.z), blo(a.w), bhi(a.w)};
    const float x2[8] = {blo(b.x), bhi(b.x), blo(b.y), bhi(b.y), blo(b.z), bhi(b.z), blo(b.w), bhi(b.w)};
    const float cc[8] = {c0.x, c0.y, c0.z, c0.w, c1.x, c1.y, c1.z, c1.w};
    const float sv[8] = {s0.x, s0.y, s0.z, s0.w, s1.x, s1.y, s1.z, s1.w};
    float o1[8], o2[8];
#pragma unroll
    for (int e = 0; e < 8; ++e) { o1[e] = x1[e] * cc[e] - x2[e] * sv[e]; o2[e] = x1[e] * sv[e] + x2[e] * cc[e]; }
    *(uint4*)(dst + c * 8) = make_uint4(pk2(o1[0], o1[1]), pk2(o1[2], o1[3]), pk2(o1[4], o1[5]), pk2(o1[6], o1[7]));
    *(uint4*)(dst + 32 + c * 8) = make_uint4(pk2(o2[0], o2[1]), pk2(o2[2], o2[3]), pk2(o2[4], o2[5]), pk2(o2[6], o2[7]));
  }
}

enum { M_MLA = 0, M_MEM = 1, M_CMP1 = 2, M_CMP2 = 3, M_SLC = 4, M_WIN = 5 };
struct KVSrc { const bfu *k1, *k2, *v; int ldk1, ldk2, ldv; };
template <int DQK> struct KVRegs { uint4 k[DQK / 64]; uint4 v[2]; };

template <int DQK>
DI void kv_gload(KVRegs<DQK>& r, const KVSrc& s, int key0, int tid) {
  const int key = tid >> 3, kq = tid & 7;
  const unsigned o1 = (unsigned)(key0 + key) * (unsigned)s.ldk1 + kq * 8;
  r.k[0] = *(const uint4*)(s.k1 + o1);
  r.k[1] = *(const uint4*)(s.k1 + o1 + 64);
  if (DQK == 192) { const unsigned o2 = (unsigned)(key0 + key) * (unsigned)s.ldk2 + kq * 8; r.k[DQK / 64 - 1] = *(const uint4*)(s.k2 + o2); }
  const unsigned ov = (unsigned)(key0 + (tid & 63)) * (unsigned)s.ldv + (tid >> 6) * 8;
  r.v[0] = *(const uint4*)(s.v + ov);
  r.v[1] = *(const uint4*)(s.v + ov + 64);
}
DI void st_b16(bfu* p, unsigned w, int hi) { *p = (bfu)(hi ? (w >> 16) : (w & 0xffffu)); }
template <int DQK>
DI void kv_sstore(const KVRegs<DQK>& r, bfu* sK, bfu* sVt, int tid) {
  constexpr int LDK = DQK + 8;
  const int key = tid >> 3, kq = tid & 7;
#pragma unroll
  for (int i = 0; i < DQK / 64; ++i)
    *(uint4*)(sK + key * LDK + (kq + 8 * i) * 8) = make_uint4(r.k[i].x, r.k[i].y, r.k[i].z, r.k[i].w);
  const int vk = tid & 63;
  const int pos = (vk & 48) + ((vk & 4) << 1) + ((vk & 8) >> 1) + (vk & 3);
#pragma unroll
  for (int i = 0; i < 2; ++i) {
    bfu* base = sVt + (((tid >> 6) + 8 * i) * 8) * 72 + pos;
    const unsigned w0 = r.v[i].x, w1 = r.v[i].y, w2 = r.v[i].z, w3 = r.v[i].w;
    base[0 * 72] = (bfu)(w0 & 0xffffu); base[1 * 72] = (bfu)(w0 >> 16);
    base[2 * 72] = (bfu)(w1 & 0xffffu); base[3 * 72] = (bfu)(w1 >> 16);
    base[4 * 72] = (bfu)(w2 & 0xffffu); base[5 * 72] = (bfu)(w2 >> 16);
    base[6 * 72] = (bfu)(w3 & 0xffffu); base[7 * 72] = (bfu)(w3 >> 16);
  }
}

struct LaneCtx {
  int t;
  float slope2;
  unsigned long long selmask;
  float invl;
  float carry;
  float* slab;
  int twave_min, twave_max;
};

template <int DQK, int MODE>
DI void attn_tile(const bf16x8 (&q)[DQK / 16], f32x16 (&o)[4], float& m, float& l, LaneCtx& cx, int jt, const bfu* sK, const bfu* sVt, int lane) {
  constexpr int LDK = DQK + 8;
  constexpr bool ISCMP = (MODE == M_CMP1 || MODE == M_CMP2);
  const int h = lane >> 5;
  const int key0 = jt * 64;
  bool sel = true;
  if (MODE == M_SLC) sel = (cx.selmask >> jt) & 1ull;
#pragma unroll
  for (int sub = 0; sub < 2; ++sub) {
    const int kb0 = key0 + 32 * sub;
    if (MODE == M_MLA) { if (kb0 > cx.twave_max) continue; }
    f32x16 s0;
#pragma unroll
    for (int i = 0; i < 16; ++i) s0[i] = 0.f;
    {
      const bfu* p = sK + (sub * 32 + (lane & 31)) * LDK + 8 * h;
#pragma unroll
      for (int ks = 0; ks < DQK / 16; ++ks) {
        bf16x8 a0 = *(const bf16x8*)(p + 16 * ks);
        s0 = __builtin_amdgcn_mfma_f32_32x32x16_bf16(a0, q[ks], s0, 0, 0, 0);
      }
    }
    if (MODE != M_MEM) {
      bool domask = true;
      if (MODE == M_MLA) domask = (kb0 + 31 > cx.twave_min);
      if (domask) {
        constexpr float KST = ISCMP ? 16.f : 1.f;
        const float vmax = ISCMP ? -15.5f : 0.f;
        float fd;
        if (ISCMP) fd = (float)(16 * (kb0 + 4 * h) - cx.t) + 15.5f;
        else fd = (float)(kb0 + 4 * h - cx.t);
#pragma unroll
        for (int i = 0; i < 16; ++i) {
          const float c0 = KST * (float)((i & 3) + 8 * (i >> 2));
          float d0 = fd + c0;
          bool v0 = (d0 <= vmax) && sel;
          if (MODE == M_WIN) v0 = v0 && (d0 > -512.f);
          float x0 = s0[i];
          if (MODE != M_MLA) x0 = fmaf(cx.slope2, d0, x0);
          s0[i] = v0 ? x0 : -INFINITY;
        }
      }
    }
    if (MODE == M_CMP2) {
      const float mm = m, il = cx.invl;
#pragma unroll
      for (int i = 0; i < 16; ++i) s0[i] = __builtin_amdgcn_exp2f(s0[i] - mm) * il;
      float sum4[4], recv[4];
#pragma unroll
      for (int a = 0; a < 4; ++a) sum4[a] = s0[4 * a] + s0[4 * a + 1] + s0[4 * a + 2] + s0[4 * a + 3];
      recv[0] = __shfl_xor(s0[3], 32); recv[1] = __shfl_xor(s0[7], 32); recv[2] = __shfl_xor(s0[11], 32); recv[3] = __shfl_xor(s0[15], 32);
      const float p0 = h ? recv[0] : cx.carry;
      const float p1 = h ? recv[1] : recv[0];
      const float p2 = h ? recv[2] : recv[1];
      const float p3 = h ? recv[3] : recv[2];
      cx.carry = recv[3];
      const int G = jt * 16 + sub * 8 + h;
      cx.slab[G] = sum4[0] + p0; cx.slab[G + 2] = sum4[1] + p1; cx.slab[G + 4] = sum4[2] + p2; cx.slab[G + 6] = sum4[3] + p3;
    } else {
      float mx = s0[0];
#pragma unroll
      for (int i = 1; i < 16; ++i) mx = fmaxf(mx, s0[i]);
      mx = xhalf_max(mx);
      const float mn = fmaxf(m, mx);
      const float alpha = __builtin_amdgcn_exp2f(m - mn);
      m = mn;
      float ps = 0.f;
#pragma unroll
      for (int i = 0; i < 16; ++i) { s0[i] = __builtin_amdgcn_exp2f(s0[i] - mn); ps += s0[i]; }
      l = l * alpha + ps;
      if (MODE != M_CMP1) {
        if (!__all(alpha == 1.f)) {
#pragma unroll
          for (int dt = 0; dt < 4; ++dt)
#pragma unroll
            for (int i = 0; i < 16; ++i) o[dt][i] *= alpha;
        }
      }
    }
    if (MODE != M_CMP1) {
      const bfu* p = sVt + (lane & 31) * 72 + 8 * h + 32 * sub;
#pragma unroll
      for (int s2 = 0; s2 < 2; ++s2) {
        const int bs = 8 * s2;
        u32x4 w;
        w[0] = pk2(s0[bs], s0[bs + 1]); w[1] = pk2(s0[bs + 2], s0[bs + 3]); w[2] = pk2(s0[bs + 4], s0[bs + 5]); w[3] = pk2(s0[bs + 6], s0[bs + 7]);
        bf16x8 pb = __builtin_bit_cast(bf16x8, w);
#pragma unroll
        for (int dt = 0; dt < 4; ++dt) {
          bf16x8 a = *(const bf16x8*)(p + dt * 32 * 72 + 16 * s2);
          o[dt] = __builtin_amdgcn_mfma_f32_32x32x16_bf16(a, pb, o[dt], 0, 0, 0);
        }
      }
    }
  }
}

template <int DQK, int MODE>
DI void flash(const bf16x8 (&q)[DQK / 16], f32x16 (&o)[4], float& m, float& l, LaneCtx& cx, const KVSrc& src,
              unsigned long long tilemask, bfu* sK, bfu* sVt) {
  const int tid = otid(), lane = tid & 63;
  unsigned lo = __builtin_amdgcn_readfirstlane((unsigned)tilemask), hi = __builtin_amdgcn_readfirstlane((unsigned)(tilemask >> 32));
  unsigned long long rem = ((unsigned long long)hi << 32) | lo;
  if (rem == 0ull) return;
  int j = __builtin_ctzll(rem); rem &= rem - 1;
  KVRegs<DQK> r;
  kv_gload<DQK>(r, src, j * 64, tid);
  kv_sstore<DQK>(r, sK, sVt, tid);
  __syncthreads();
  while (true) {
    int jn = -1;
    if (rem != 0ull) { jn = __builtin_ctzll(rem); rem &= rem - 1; kv_gload<DQK>(r, src, jn * 64, tid); }
    attn_tile<DQK, MODE>(q, o, m, l, cx, j, sK, sVt, lane);
    __syncthreads();
    if (jn < 0) break;
    kv_sstore<DQK>(r, sK, sVt, tid);
    __syncthreads();
    j = jn;
  }
}

DI unsigned long long bits_upto(int n) { return n >= 64 ? ~0ull : ((1ull << n) - 1ull); }

template <int DQK>
DI void load_q(bf16x8 (&q)[DQK / 16], const bfu* Q, long ldq, int lane) {
  const bfu* p = Q + (long)(lane & 31) * ldq + 8 * (lane >> 5);
#pragma unroll
  for (int ks = 0; ks < DQK / 16; ++ks) q[ks] = *(const bf16x8*)(p + 16 * ks);
}
DI void rope_q(bf16x8 (&q)[12], const float* cs, const float* sn, int pos, int h) {
#pragma unroll
  for (int kk = 0; kk < 2; ++kk) {
    const int i0 = 16 * kk + 8 * h;
    const float4 c0 = *(const float4*)(cs + pos * 32 + i0), c1 = *(const float4*)(cs + pos * 32 + i0 + 4);
    const float4 s0 = *(const float4*)(sn + pos * 32 + i0), s1 = *(const float4*)(sn + pos * 32 + i0 + 4);
    const float cc[8] = {c0.x, c0.y, c0.z, c0.w, c1.x, c1.y, c1.z, c1.w};
    const float sv[8] = {s0.x, s0.y, s0.z, s0.w, s1.x, s1.y, s1.z, s1.w};
    u32x4 a = __builtin_bit_cast(u32x4, q[8 + kk]), b = __builtin_bit_cast(u32x4, q[10 + kk]);
    u32x4 oa, ob;
#pragma unroll
    for (int w = 0; w < 4; ++w) {
      const float x1l = blo(a[w]), x1h = bhi(a[w]), x2l = blo(b[w]), x2h = bhi(b[w]);
      oa[w] = pk2(x1l * cc[2 * w] - x2l * sv[2 * w], x1h * cc[2 * w + 1] - x2h * sv[2 * w + 1]);
      ob[w] = pk2(x1l * sv[2 * w] + x2l * cc[2 * w], x1h * sv[2 * w + 1] + x2h * cc[2 * w + 1]);
    }
    q[8 + kk] = __builtin_bit_cast(bf16x8, oa); q[10 + kk] = __builtin_bit_cast(bf16x8, ob);
  }
}

DI void store_gated(const f32x16 (&o)[4], float sc, const bfu* zs, bfu* dst, int h) {
#pragma unroll
  for (int dt = 0; dt < 4; ++dt)
#pragma unroll
    for (int g = 0; g < 4; ++g) {
      int d = 32 * dt + 8 * g + 4 * h;
      uint2 z = *(const uint2*)(zs + d);
      uint2 w;
      w.x = pk2(o[dt][4 * g] * sc * blo(z.x), o[dt][4 * g + 1] * sc * bhi(z.x));
      w.y = pk2(o[dt][4 * g + 2] * sc * blo(z.y), o[dt][4 * g + 3] * sc * bhi(z.y));
      *(uint2*)(dst + d) = w;
    }
}

DI void mla_item(const Params& P, int b, int head, int qt, char* smem) {
  char* ws = P.ws;
  bfu* sK = (bfu*)smem; bfu* sVt = (bfu*)(smem + 25600);
  const int tid = otid(), lane = tid & 63, wave = tid >> 6, h = lane >> 5, ql = lane & 31;
  const int tq0 = qt * 256 + wave * 32;
  const long tok0 = (long)b * SEQ + tq0;
  bf16x8 q[12];
  load_q<192>(q, (const bfu*)(ws + O_QMLA) + tok0 * 1536 + head * 192, 1536, lane);
  rope_q(q, (const float*)(ws + O_COS), (const float*)(ws + O_SIN), tq0 + ql, h);
  KVSrc src;
  src.k1 = (const bfu*)(ws + O_KNOPE) + (long)b * SEQ * 1024 + head * 128; src.ldk1 = 1024;
  src.k2 = (const bfu*)(ws + O_KPE) + (long)b * SEQ * 64; src.ldk2 = 64;
  src.v = (const bfu*)(ws + O_VMLA) + (long)b * SEQ * 1024 + head * 128; src.ldv = 1024;
  LaneCtx cx; cx.t = tq0 + ql; cx.slope2 = 0.f; cx.selmask = 0; cx.invl = 0.f; cx.carry = 0.f; cx.slab = nullptr; cx.twave_min = tq0; cx.twave_max = tq0 + 31;
  f32x16 o[4];
#pragma unroll
  for (int dt = 0; dt < 4; ++dt)
#pragma unroll
    for (int i = 0; i < 16; ++i) o[dt][i] = 0.f;
  float m = -1e30f, l = 0.f;
  flash<192, M_MLA>(q, o, m, l, cx, src, bits_upto(4 * (qt + 1)), sK, sVt);
  const float lt = xhalf_sum(l);
  const float sc = 1.f / (lt + 1e-20f);
  const long tok = tok0 + ql;
  store_gated(o, sc, (const bfu*)(ws + O_ZS) + tok * 2048 + head * 128, (bfu*)(ws + O_OCAT) + tok * 2048 + head * 128, h);
}

DI void mem_item(const Params& P, int b, int head, int qt, char* smem) {
  char* ws = P.ws;
  bfu* sK = (bfu*)smem; bfu* sVt = (bfu*)(smem + 25600);
  const int tid = otid(), lane = tid & 63, wave = tid >> 6, h = lane >> 5, ql = lane & 31;
  const int tq0 = qt * 256 + wave * 32;
  const long tok0 = (long)b * SEQ + tq0;
  bf16x8 q[8];
  load_q<128>(q, (const bfu*)(ws + O_QMEM) + tok0 * 512 + head * 128, 512, lane);
  KVSrc src;
  src.k1 = (const bfu*)(ws + O_MEMK) + (long)b * 256 * 512 + head * 128; src.ldk1 = 512;
  src.k2 = src.k1; src.ldk2 = 512;
  src.v = (const bfu*)(ws + O_MEMV) + (long)b * 256 * 512 + head * 128; src.ldv = 512;
  LaneCtx cx; cx.t = 0; cx.slope2 = 0.f; cx.selmask = 0; cx.invl = 0.f; cx.carry = 0.f; cx.slab = nullptr; cx.twave_min = 0; cx.twave_max = 0;
  f32x16 o[4];
#pragma unroll
  for (int dt = 0; dt < 4; ++dt)
#pragma unroll
    for (int i = 0; i < 16; ++i) o[dt][i] = 0.f;
  float m = -1e30f, l = 0.f;
  flash<128, M_MEM>(q, o, m, l, cx, src, 0xFull, sK, sVt);
  const float lt = xhalf_sum(l);
  const float sc = 1.f / lt;
  const long tok = tok0 + ql;
  store_gated(o, sc, (const bfu*)(ws + O_ZS) + tok * 2048 + 1536 + head * 128, (bfu*)(ws + O_OCAT) + tok * 2048 + 1536 + head * 128, h);
}

DI void onsa_acc(const f32x16 (&o)[4], float sc, float* dst, int h, bool add) {
#pragma unroll
  for (int dt = 0; dt < 4; ++dt)
#pragma unroll
    for (int g = 0; g < 4; ++g) {
      int d = 32 * dt + 8 * g + 4 * h;
      float4 v = make_float4(o[dt][4 * g] * sc, o[dt][4 * g + 1] * sc, o[dt][4 * g + 2] * sc, o[dt][4 * g + 3] * sc);
      if (add) { float4 p = *(const float4*)(dst + d); v.x += p.x; v.y += p.y; v.z += p.z; v.w += p.w; }
      *(float4*)(dst + d) = v;
    }
}

DI void nsa_item(const Params& P, int b, int qt, char* smem) {
  char* ws = P.ws;
  bfu* sK = (bfu*)smem; bfu* sVt = (bfu*)(smem + 25600);
  float* slab = (float*)(smem + 45056);
  unsigned long long* selm = (unsigned long long*)(smem + 110592);
  const int tid = otid(), lane = tid & 63, wave = tid >> 6, h = lane >> 5, ql = lane & 31;
  const int head = wave & 3, qsub = wave >> 2;
  const int t0 = qt * 64;
  const int t0w = t0 + qsub * 32;
  const long tok = (long)b * SEQ + t0w + ql;
  bf16x8 q[12];
  load_q<192>(q, (const bfu*)(ws + O_QNSA) + ((long)b * SEQ + t0w) * 768 + head * 192, 768, lane);
  float* onsa = (float*)(ws + O_ONSA) + tok * 512 + head * 128;
  LaneCtx cx; cx.t = t0w + ql; cx.slope2 = exp2f(-2.f * (float)(head + 1)) * LOG2E; cx.selmask = 0; cx.invl = 0.f; cx.carry = 0.f;
  cx.slab = slab + (wave * 32 + ql) * 64; cx.twave_min = t0w; cx.twave_max = t0w + 31;
#pragma unroll
  for (int i = 0; i < 32; ++i) slab[tid + NTHR * i] = 0.f;
  __syncthreads();
  f32x16 o[4];
  float m, l;
  {
    KVSrc src;
    src.k1 = (const bfu*)(ws + O_KCMP) + (long)b * 256 * 192; src.ldk1 = 192;
    src.k2 = src.k1 + 128; src.ldk2 = 192;
    src.v = (const bfu*)(ws + O_VCMP) + (long)b * 256 * 128; src.ldv = 128;
    const int ntc = (((t0 + 32) >> 4) >> 6) + 1;
    m = -1e30f; l = 0.f;
    flash<192, M_CMP1>(q, o, m, l, cx, src, bits_upto(ntc), sK, sVt);
    const float lt = xhalf_sum(l);
    cx.invl = 1.f / (lt + 1e-20f);
#pragma unroll
    for (int dt = 0; dt < 4; ++dt)
#pragma unroll
      for (int i = 0; i < 16; ++i) o[dt][i] = 0.f;
    flash<192, M_CMP2>(q, o, m, l, cx, src, bits_upto(ntc), sK, sVt);
    const float g0 = ((const float*)(ws + O_GATES))[tok * 16 + head * 3 + 0];
    onsa_acc(o, g0, onsa, h, false);
  }
  __syncthreads();
  const int cur = qt;
  for (int qi = 0; qi < 8; ++qi) {
    const int qq = wave * 8 + qi;
    const float* sl = slab + (((qq >> 5) * 4) * 32 + (qq & 31)) * 64 + lane;
    float v = sl[0] + sl[32 * 64] + sl[2 * 32 * 64] + sl[3 * 32 * 64];
    const bool forced = (lane == 0) || (lane == cur) || (lane == cur - 1);
    if (forced) v = 1e9f;
    if (lane > cur) v = -1e9f;
    int rank = 0;
#pragma unroll
    for (int j = 0; j < 64; ++j) {
      float vj = __builtin_bit_cast(float, __builtin_amdgcn_readlane(__builtin_bit_cast(int, v), j));
      rank += ((vj > v) || (vj == v && j < lane)) ? 1 : 0;
    }
    unsigned long long msk = __ballot(rank < 16);
    if (lane == 0) selm[qq] = msk;
  }
  __syncthreads();
  {
    const unsigned long long allm = selm[lane];
    unsigned ulo = (unsigned)allm, uhi = (unsigned)(allm >> 32);
#pragma unroll
    for (int off = 32; off >= 1; off >>= 1) { ulo |= __shfl_xor(ulo, off); uhi |= __shfl_xor(uhi, off); }
    unsigned long long uni = (((unsigned long long)uhi) << 32) | ulo;
    uni &= bits_upto(cur + 1);
    cx.selmask = selm[qsub * 32 + ql];
    KVSrc src;
    src.k1 = (const bfu*)(ws + O_KS) + (long)b * SEQ * 192; src.ldk1 = 192;
    src.k2 = src.k1 + 128; src.ldk2 = 192;
    src.v = (const bfu*)(ws + O_VS) + (long)b * SEQ * 128; src.ldv = 128;
    m = -1e30f; l = 0.f;
#pragma unroll
    for (int dt = 0; dt < 4; ++dt)
#pragma unroll
      for (int i = 0; i < 16; ++i) o[dt][i] = 0.f;
    flash<192, M_SLC>(q, o, m, l, cx, src, uni, sK, sVt);
    const float lt = xhalf_sum(l);
    const float g1 = ((const float*)(ws + O_GATES))[tok * 16 + head * 3 + 1];
    onsa_acc(o, g1 / (lt + 1e-20f), onsa, h, true);
  }
  {
    KVSrc src;
    src.k1 = (const bfu*)(ws + O_KW) + (long)b * SEQ * 192; src.ldk1 = 192;
    src.k2 = src.k1 + 128; src.ldk2 = 192;
    src.v = (const bfu*)(ws + O_VW) + (long)b * SEQ * 128; src.ldv = 128;
    int lo_t = t0 - 511; if (lo_t < 0) lo_t = 0;
    const int j0 = lo_t >> 6, j1 = qt;
    unsigned long long tm = bits_upto(j1 + 1) & ~bits_upto(j0);
    m = -1e30f; l = 0.f;
#pragma unroll
    for (int dt = 0; dt < 4; ++dt)
#pragma unroll
      for (int i = 0; i < 16; ++i) o[dt][i] = 0.f;
    flash<192, M_WIN>(q, o, m, l, cx, src, tm, sK, sVt);
    const float lt = xhalf_sum(l);
    const float g2 = ((const float*)(ws + O_GATES))[tok * 16 + head * 3 + 2];
    const float sc = g2 / (lt + 1e-20f);
    const bfu* zs = (const bfu*)(ws + O_ZS) + tok * 2048 + 1024 + head * 128;
    bfu* dst = (bfu*)(ws + O_OCAT) + tok * 2048 + 1024 + head * 128;
#pragma unroll
    for (int dt = 0; dt < 4; ++dt)
#pragma unroll
      for (int g = 0; g < 4; ++g) {
        int d = 32 * dt + 8 * g + 4 * h;
        float4 p = *(const float4*)(onsa + d);
        uint2 z = *(const uint2*)(zs + d);
        uint2 w;
        w.x = pk2((p.x + o[dt][4 * g] * sc) * blo(z.x), (p.y + o[dt][4 * g + 1] * sc) * bhi(z.x));
        w.y = pk2((p.z + o[dt][4 * g + 2] * sc) * blo(z.y), (p.w + o[dt][4 * g + 3] * sc) * bhi(z.y));
        *(uint2*)(dst + d) = w;
      }
  }
}

__global__ void __launch_bounds__(512) mega(Params P) {
  extern __shared__ __attribute__((aligned(16))) char smem[];
  cg::grid_group grid = cg::this_grid();
  char* ws = P.ws;
  const int tid = threadIdx.x;
  unsigned* bar = (unsigned*)(ws + O_CTR);
  unsigned* qbase = (unsigned*)(ws + O_Q);
  int* s_item = (int*)(smem + SMEM_BYTES - 16);
  volatile LAS unsigned* st = (volatile LAS unsigned*)(smem + SMEM_BYTES - 32);
  if (tid == 0) { st[0] = 0u; st[1] = 0u; }
  __syncthreads();
  XcdBarrier xb = xcd_barrier_post(bar, st);
  if (P.phase_hi > 1000) grid.sync();
#define RUNPH(n) (P.phase_lo <= (n) && (n) <= P.phase_hi)
#define SYNCPH(n) if (P.phase_lo <= (n) && (n) < P.phase_hi) xcd_barrier(xb);
  if (RUNPH(0)) phase0(P, smem);
  SYNCPH(0)
  if (RUNPH(1)) {
    pg8::Gemm g{(const bfu*)(ws + O_XN), (const bfu*)(ws + O_WT_IN), 0, 0, 2048};
    pg8::Sched2 S{(int)gridDim.x, (int)blockIdx.x, 64, 22, 4, 4, 64, 22};
    EpiP1 e{ws};
    pg8::gemm_phase<EpiP1, pg8::Sched2>((PG8_LAS unsigned char*)smem, g, S, e);
  }
  SYNCPH(1)
  if (RUNPH(2)) {
    for (int it = blockIdx.x; it < 64 + 192; it += gridDim.x) {
      if (it < 64) kpe_rope_item(ws, it);
      else {
        int c = it - 64;
        if (c < 128) { int tile = c >> 3, ch = c & 7; EpiC1 e{(const float*)(ws + O_BIASK), (float*)(ws + O_PARTK), 192, ch};
          gemm_tile<false>((const bfu*)(ws + O_KC) + ch * 768, 3072, (const bfu*)(ws + O_WT_C1K) + ch * 768, 6144, 768, (tile >> 1) * 128, (tile & 1) * 128, e, smem); }
        else { c -= 128; int mt = c >> 3, ch = c & 7; EpiC1 e{(const float*)(ws + O_BIASV), (float*)(ws + O_PARTV), 128, ch};
          gemm_tile<false>((const bfu*)(ws + O_VC) + ch * 512, 2048, (const bfu*)(ws + O_WT_C1V) + ch * 512, 4096, 512, mt * 128, 0, e, smem); }
      }
    }
    __syncthreads();
    pg8::Gemm g{(const bfu*)(ws + O_CQ), (const bfu*)(ws + O_WT_UQ), 0, 0, 512};
    pg8::Sched2 S{(int)gridDim.x, (int)blockIdx.x, 64, 6, 64, 8, 64, 6};
    EpiP2 e{ws};
    pg8::gemm_phase<EpiP2, pg8::Sched2>((PG8_LAS unsigned char*)smem, g, S, e);
  }
  SYNCPH(2)
  if (RUNPH(3)) {
    for (int it = blockIdx.x; it < 24; it += gridDim.x) {
      if (it < 16) { EpiC2 e{(bfu*)(ws + O_KCMP), 192};
        gemm_tile<true>((const bfu*)(ws + O_PARTK), 192, (const bfu*)(ws + O_WT_C2K), 192, 192, (it >> 1) * 128, (it & 1) * 128, e, smem); }
      else { int i = it - 16; EpiC2 e{(bfu*)(ws + O_VCMP), 128};
        gemm_tile<true>((const bfu*)(ws + O_PARTV), 128, (const bfu*)(ws + O_WT_C2V), 128, 128, i * 128, 0, e, smem); }
    }
  }
  SYNCPH(3)
  if (RUNPH(4)) {
    unsigned* ctr = qbase;
    while (true) {
      if (tid == 0) *s_item = (int)atomicAdd(ctr, 1u);
      __syncthreads();
      const int it = *s_item;
      __syncthreads();
      if (it >= 1024) break;
      if (it < 256 || (it >= 512 && it < 768)) { int i = (it < 256) ? it : it - 256; int qt = 15 - (i >> 5), bh = i & 31; mla_item(P, bh >> 3, bh & 7, qt, smem); }
      else if (it < 512) { int i = it - 256; nsa_item(P, i & 3, 63 - (i >> 2), smem); }
      else { int i = it - 768; mem_item(P, i >> 6, (i >> 4) & 3, i & 15, smem); }
    }
  }
  SYNCPH(4)
  if (RUNPH(5)) {
    pg8::Gemm g{(const bfu*)(ws + O_OCAT), (const bfu*)(ws + O_WT_OUT), 0, 0, 2048};
    pg8::Sched2 S{(int)gridDim.x, (int)blockIdx.x, 64, 8, 0, 1, 0, 0};
    EpiP5 e{P.x, P.out, (float*)(ws + O_SSQP)};
    pg8::gemm_phase<EpiP5, pg8::Sched2>((PG8_LAS unsigned char*)smem, g, S, e);
  }
  SYNCPH(5)
  if (RUNPH(6)) {
    const int lane = tid & 63, wave = tid >> 6;
    const float* sp = (const float*)(ws + O_SSQP);
    for (int it = blockIdx.x; it < NTOK / 8; it += gridDim.x) {
      const int row = it * 8 + wave;
      float s = (lane < 32) ? sp[(long)row * 32 + lane] : 0.f;
      s = wave_sum(s);
      const float r = rsqrtf(s * (1.f / 2048.f) + EPS);
      float4* o4 = (float4*)(P.out + (long)row * DM);
#pragma unroll
      for (int i = 0; i < 8; ++i) {
        float4 v = o4[lane + 64 * i]; float4 g = ((const float4*)P.final_g)[lane + 64 * i];
        v.x *= r * g.x; v.y *= r * g.y; v.z *= r * g.z; v.w *= r * g.w;
        o4[lane + 64 * i] = v;
      }
    }
  }
}

extern "C" void kernel_launch(void* const* d_in, const int* in_sizes, int n_in, void* d_out, int out_size, void* d_ws, size_t ws_size,
                              hipStream_t stream) {
  static int grid_blocks = 0;
  if (!grid_blocks) {
    int dev = 0, cus = 0, per_cu = 0;
    (void)hipGetDevice(&dev);
    (void)hipDeviceGetAttribute(&cus, hipDeviceAttributeMultiprocessorCount, dev);
    (void)hipFuncSetAttribute((const void*)mega, hipFuncAttributeMaxDynamicSharedMemorySize, SMEM_BYTES);
    (void)hipOccupancyMaxActiveBlocksPerMultiprocessor(&per_cu, mega, NTHR, SMEM_BYTES);
    if (per_cu < 1) per_cu = 1;
    if (per_cu > 1) per_cu = 1;
    grid_blocks = cus * per_cu;
    if (ws_size < WS_TOTAL) fprintf(stderr, "workspace too small: %zu < %zu\n", ws_size, (size_t)WS_TOTAL);
  }
  Params p{};
  p.x = (const float*)d_in[0]; p.mem = (const float*)d_in[1]; p.norm_g = (const float*)d_in[2]; p.w_in = (const float*)d_in[3];
  p.q_norm_g = (const float*)d_in[4]; p.w_uq = (const float*)d_in[5]; p.kv_norm_g = (const float*)d_in[6]; p.w_ukv = (const float*)d_in[7];
  p.cmp_pe_k = (const float*)d_in[8]; p.cmp_pe_v = (const float*)d_in[9]; p.cmp_w1k = (const float*)d_in[10]; p.cmp_w2k = (const float*)d_in[11];
  p.cmp_w1v = (const float*)d_in[12]; p.cmp_w2v = (const float*)d_in[13]; p.mem_norm_g = (const float*)d_in[14]; p.w_mem_kv = (const float*)d_in[15];
  p.w_out = (const float*)d_in[16]; p.final_g = (const float*)d_in[17];
  p.out = (float*)d_out; p.ws = (char*)d_ws;
  (void)hipMemsetAsync((char*)d_ws + O_CTR, 0, CTR_BYTES, stream);
#if MULTI_LAUNCH
  for (int ph = 0; ph <= 6; ++ph) {
    p.phase_lo = ph; p.phase_hi = ph;
    hipLaunchKernelGGL(mega, dim3(grid_blocks), dim3(NTHR), SMEM_BYTES, stream, p);
  }
#else
  p.phase_lo = 0; p.phase_hi = 6;
  void* args[] = {&p};
  hipError_t e = hipLaunchCooperativeKernel((void*)mega, dim3(grid_blocks), dim3(NTHR), args, SMEM_BYTES, stream);
  if (e != hipSuccess) fprintf(stderr, "cooperative launch failed: %s (grid %d)\n", hipGetErrorString(e), grid_blocks);
#endif
}
```
